# Optimizing an MI355X kernel written in HIP

```python
import math
import jax
import jax.numpy as jnp
from jax import lax
import numpy as np

D_MODEL = 1024
BATCH = 2
SEQ = 8192
DEPTH = 2

GRID_W = 64
CTX_LEN = 256
NORM_EPS = 1e-6
N_MOD = 6

D_MIX = D_MODEL
N_MIXERS = 4
GROUP_WIDTH = D_MIX // N_MIXERS

SSD_WIDTH = GROUP_WIDTH
SSD_HEAD_DIM = 64
SSD_HEADS = SSD_WIDTH // SSD_HEAD_DIM
SSD_GROUPS = 2
SSD_STATE = 128
SSD_CONV = 5
SSD_CHUNK = 128
SSD_CONV_CH = SSD_WIDTH + 2 * SSD_GROUPS * SSD_STATE
SSD_IN = SSD_WIDTH + SSD_CONV_CH + 2 * SSD_HEADS

GLA_WIDTH = GROUP_WIDTH
GLA_HEADS = 4
GLA_DV = GLA_WIDTH // GLA_HEADS
GLA_DK = GLA_DV // 2
GLA_QK = GLA_HEADS * GLA_DK
GLA_GATE_RANK = 16
GLA_TAU = 16.0
GLA_CHUNK = 64
GLA_IN = 2 * GLA_QK + 2 * GLA_WIDTH + 2 * GLA_GATE_RANK

MLA_WIDTH = GROUP_WIDTH
MLA_HEADS = 4
MLA_V = MLA_WIDTH // MLA_HEADS
MLA_NOPE = 64
MLA_ROPE = 32
MLA_Q_RANK = 256
MLA_KV_RANK = 128
MLA_QBLOCK = 128
MLA_SCALE = (MLA_NOPE + MLA_ROPE) ** -0.5
ROPE_BASE = 10000.0
MLA_IN = MLA_Q_RANK + MLA_KV_RANK + MLA_ROPE

S5_WIDTH = GROUP_WIDTH
S5_GROUP = 16
S5_NGROUPS = S5_WIDTH // S5_GROUP
S5_STATE = 64
S5_MAX_RE = -1e-4
S5_IN = S5_WIDTH

D_IN = SSD_IN + GLA_IN + MLA_IN + S5_IN

PEER_KEYS = 128
PEER_EXPERTS = PEER_KEYS * PEER_KEYS
PEER_HEADS = 8
PEER_TOPK = 16
PEER_DQ = 128
PEER_BLOCK = 128

kernel_name = 'hybrid_parallel_heads_peer_flow_block'


def _rmsnorm(x, g):
    xf = x.astype(jnp.float32)
    y = xf * lax.rsqrt(jnp.mean(xf * xf, axis=-1, keepdims=True) + NORM_EPS)
    return y.astype(x.dtype) * g


def _modulate(x, g, shift, scale):
    return _rmsnorm(x, g) * (1 + scale) + shift


def _split(t, sizes):
    out, start = [], 0
    for s in sizes:
        out.append(t[..., start:start + s])
        start += s
    return out


def _dwconv_centered(x, w, b):
    k = w.shape[0]
    left = k // 2
    y = lax.conv_general_dilated(x, w[:, None, :].astype(x.dtype), window_strides=(1,),
                                 padding=[(left, k - 1 - left)],
                                 dimension_numbers=('NWC', 'WIO', 'NWC'),
                                 feature_group_count=x.shape[-1])
    return y + b


def _bidirectional_with_prefix(scan_f, scan_b, ctx_seq, lat_seq, h0):
    flip = lambda seq: tuple(jnp.flip(a, axis=1) for a in seq)
    yc_f, hc_f = scan_f(ctx_seq, h0)
    yc_b, hc_b = scan_b(flip(ctx_seq), h0)
    yl_f, _ = scan_f(lat_seq, hc_f)
    yl_b, _ = scan_b(flip(lat_seq), hc_b)
    return yc_f + jnp.flip(yc_b, axis=1), yl_f + jnp.flip(yl_b, axis=1)


def _ssd_chunk_scan(x, dt, a_head, bm, cm, h0):
    bsz, length, nh, hp = x.shape
    ns = bm.shape[-1]
    nc = length // SSD_CHUNK
    a = (dt * a_head).reshape(bsz, nc, SSD_CHUNK, nh)
    xd = (x * dt[..., None]).reshape(bsz, nc, SSD_CHUNK, nh, hp)
    bm = bm.reshape(bsz, nc, SSD_CHUNK, nh, ns)
    cm = cm.reshape(bsz, nc, SSD_CHUNK, nh, ns)
    acum = jnp.cumsum(a, axis=2)
    lower = jnp.tril(jnp.ones((SSD_CHUNK, SSD_CHUNK), bool))
    seg = acum[:, :, :, None, :] - acum[:, :, None, :, :]
    decay = jnp.exp(jnp.where(lower[None, None, :, :, None], seg, -jnp.inf))
    scores = jnp.einsum('bcihn,bcjhn->bcijh', cm, bm) * decay
    y_diag = jnp.einsum('bcijh,bcjhp->bcihp', scores, xd)
    to_end = jnp.exp(acum[:, :, -1:, :] - acum)
    states = jnp.einsum('bcjh,bcjhn,bcjhp->bchpn', to_end, bm, xd)
    chunk_decay = jnp.exp(acum[:, :, -1, :])

    def step(h, inp):
        s_c, g_c = inp
        return g_c[:, :, None, None] * h + s_c, h

    h_fin, h_in = lax.scan(step, h0, (jnp.moveaxis(states, 1, 0), jnp.moveaxis(chunk_decay, 1, 0)))
    h_in = jnp.moveaxis(h_in, 0, 1)
    y_off = jnp.einsum('bcihn,bchpn->bcihp', cm, h_in) * jnp.exp(acum)[..., None]
    return (y_diag + y_off).reshape(bsz, length, nh, hp), h_fin


def _ssd_mixer(pc, pl, conv_w, conv_b, a_log, dt_bias, d_skip, norm_g, ctx_out):
    f32 = jnp.float32
    dtype = pl.dtype
    rep = SSD_HEADS // SSD_GROUPS

    def prep(p):
        bsz, length = p.shape[:2]
        z, xbc, dt_raw = _split(p, (SSD_WIDTH, SSD_CONV_CH, 2 * SSD_HEADS))
        xbc = jax.nn.silu(_dwconv_centered(xbc, conv_w, conv_b)).astype(f32)
        xs, bm, cm = _split(xbc, (SSD_WIDTH, SSD_GROUPS * SSD_STATE, SSD_GROUPS * SSD_STATE))
        xs = xs.reshape(bsz, length, SSD_HEADS, SSD_HEAD_DIM)
        bm = jnp.repeat(bm.reshape(bsz, length, SSD_GROUPS, SSD_STATE), rep, axis=2)
        cm = jnp.repeat(cm.reshape(bsz, length, SSD_GROUPS, SSD_STATE), rep, axis=2)
        dt_raw = dt_raw.astype(f32).reshape(bsz, length, 2, SSD_HEADS)
        return z, (xs, bm, cm, dt_raw)

    zc, seq_c = prep(pc)
    zl, seq_l = prep(pl)

    def make_scan(d):
        a_head = -jnp.exp(a_log[d].astype(f32))
        bias = dt_bias[d].astype(f32)

        def scan(seq, h0):
            xs, bm, cm, dt_raw = seq
            dt = jax.nn.softplus(dt_raw[:, :, d] + bias)
            return _ssd_chunk_scan(xs, dt, a_head, bm, cm, h0)
        return scan

    h0 = jnp.zeros((pl.shape[0], SSD_HEADS, SSD_HEAD_DIM, SSD_STATE), f32)
    yc, yl = _bidirectional_with_prefix(make_scan(0), make_scan(1), seq_c, seq_l, h0)

    def finish(y, xs, z):
        y = y + d_skip.astype(f32)[:, None] * xs
        y = y.reshape(y.shape[0], y.shape[1], SSD_WIDTH).astype(dtype) * jax.nn.silu(z)
        return _rmsnorm(y, norm_g)

    out_c = finish(yc, seq_c[0], zc) if ctx_out else None
    return out_c, finish(yl, seq_l[0], zl)


def _gla_chunk_scan(q, k, v, logg, s0):
    bsz, length, nh, _ = q.shape
    dv = v.shape[-1]
    nc = length // GLA_CHUNK
    rs = lambda t: t.reshape(bsz, nc, GLA_CHUNK, nh, t.shape[-1])
    q, k, v, logg = rs(q), rs(k), rs(v), rs(logg)
    b = jnp.cumsum(logg, axis=2)
    qe = q * jnp.exp(b)
    ke = k * jnp.exp(-b)
    lower = jnp.tril(jnp.ones((GLA_CHUNK, GLA_CHUNK), bool))
    att = jnp.where(lower, jnp.einsum('bcihd,bcjhd->bchij', qe, ke), 0.0)
    o_intra = jnp.einsum('bchij,bcjhv->bcihv', att, v)
    b_last = b[:, :, -1]
    kd = k * jnp.exp(b_last[:, :, None] - b)
    local = jnp.einsum('bcjhd,bcjhv->bchdv', kd, v)

    def step(s, inp):
        g_c, u_c = inp
        return g_c[..., None] * s + u_c, s

    s_fin, s_in = lax.scan(step, s0, (jnp.moveaxis(jnp.exp(b_last), 1, 0), jnp.moveaxis(local, 1, 0)))
    s_in = jnp.moveaxis(s_in, 0, 1)
    o_inter = jnp.einsum('bcihd,bchdv->bcihv', qe, s_in)
    return (o_intra + o_inter).reshape(bsz, length, nh, dv), s_fin


def _gla_mixer(pc, pl, gate_w, gate_b, norm_g, ctx_out):
    f32 = jnp.float32
    dtype = pl.dtype

    def prep(p):
        bsz, length = p.shape[:2]
        q, k, v, r, glr = _split(p, (GLA_QK, GLA_QK, GLA_WIDTH, GLA_WIDTH, 2 * GLA_GATE_RANK))
        hd = lambda t, dim: t.astype(f32).reshape(bsz, length, GLA_HEADS, dim)
        seq = (hd(q, GLA_DK) * GLA_DK ** -0.5, hd(k, GLA_DK), hd(v, GLA_DV),
               glr.astype(f32).reshape(bsz, length, 2, GLA_GATE_RANK))
        return r, seq

    rc, seq_c = prep(pc)
    rl, seq_l = prep(pl)

    def make_scan(d):
        w = gate_w[d].astype(f32)
        bias = gate_b[d].astype(f32)

        def scan(seq, s0):
            q, k, v, glr = seq
            logg = (jax.nn.log_sigmoid(glr[:, :, d] @ w + bias) / GLA_TAU).reshape(q.shape)
            return _gla_chunk_scan(q, k, v, logg, s0)
        return scan

    s0 = jnp.zeros((pl.shape[0], GLA_HEADS, GLA_DK, GLA_DV), f32)
    oc, ol = _bidirectional_with_prefix(make_scan(0), make_scan(1), seq_c, seq_l, s0)

    def finish(o, r):
        o = _rmsnorm(o.astype(dtype), norm_g)
        return o.reshape(o.shape[0], o.shape[1], GLA_WIDTH) * jax.nn.silu(r)

    out_c = finish(oc, rc) if ctx_out else None
    return out_c, finish(ol, rl)


def _axial_rope(length, dtype):
    rows = length // GRID_W
    row = jnp.repeat(jnp.arange(rows, dtype=jnp.float32), GRID_W)
    col = jnp.tile(jnp.arange(GRID_W, dtype=jnp.float32), rows)
    half = MLA_ROPE // 2
    inv = ROPE_BASE ** (-jnp.arange(0, half, 2, dtype=jnp.float32) / half)
    ang = jnp.concatenate([row[:, None] * inv, col[:, None] * inv], axis=-1)
    return jnp.cos(ang).astype(dtype), jnp.sin(ang).astype(dtype)


def _apply_rope(x, cos, sin):
    h = x.shape[-1] // 2
    x1, x2 = x[..., :h], x[..., h:]
    return jnp.concatenate([x1 * cos - x2 * sin, x1 * sin + x2 * cos], axis=-1)


def _attention(q, k, v):
    s = jnp.einsum('bqhd,bkhd->bhqk', q, k).astype(jnp.float32) * MLA_SCALE
    p = jax.nn.softmax(s, axis=-1).astype(v.dtype)
    return jnp.einsum('bhqk,bkhv->bqhv', p, v)


def _block_attention(q, k, v):
    bsz, length = q.shape[:2]
    nb = length // MLA_QBLOCK
    qb = jnp.moveaxis(q.reshape(bsz, nb, MLA_QBLOCK, q.shape[2], q.shape[3]), 1, 0)
    out = lax.map(lambda blk: _attention(blk, k, v), qb)
    return jnp.moveaxis(out, 0, 1).reshape(bsz, length, out.shape[3], out.shape[4])


def _mla_mixer(pc, pl, q_norm_g, w_uq, kv_norm_g, w_ukv, ctx_out):
    def project(p):
        bsz, length = p.shape[:2]
        cq, ckv, kr = _split(p, (MLA_Q_RANK, MLA_KV_RANK, MLA_ROPE))
        q = (_rmsnorm(cq, q_norm_g) @ w_uq).reshape(bsz, length, MLA_HEADS, MLA_NOPE + MLA_ROPE)
        kv = (_rmsnorm(ckv, kv_norm_g) @ w_ukv).reshape(bsz, length, MLA_HEADS, MLA_NOPE + MLA_V)
        return q, kv[..., :MLA_NOPE], kr, kv[..., MLA_NOPE:]

    def full_keys(k_nope, k_rope):
        shared = jnp.broadcast_to(k_rope[:, :, None, :], k_nope.shape[:3] + (MLA_ROPE,))
        return jnp.concatenate([k_nope, shared], axis=-1)

    qc, knc, krc, vc = project(pc)
    ql, knl, krl, vl = project(pl)
    cos, sin = _axial_rope(pl.shape[1], pl.dtype)
    ql = jnp.concatenate([ql[..., :MLA_NOPE],
                          _apply_rope(ql[..., MLA_NOPE:], cos[:, None, :], sin[:, None, :])], axis=-1)
    krl = _apply_rope(krl, cos, sin)
    kc = full_keys(knc, krc)
    kl = full_keys(knl, krl)
    k_all = jnp.concatenate([kl, kc], axis=1)
    v_all = jnp.concatenate([vl, vc], axis=1)
    yl = _block_attention(ql, k_all, v_all)
    yl = yl.reshape(yl.shape[0], yl.shape[1], MLA_WIDTH)
    if ctx_out:
        yc = _attention(qc, kc, vc)
        yc = yc.reshape(yc.shape[0], yc.shape[1], MLA_WIDTH)
    else:
        yc = None
    return yc, yl


def _linear_recurrence_op(e1, e2):
    a1, b1 = e1
    a2, b2 = e2
    return a1 * a2, a2 * b1 + b2


def _s5_mixer(pc, pl, a_re, a_im, log_dt, b_re, b_im, c_re, c_im, d_skip, glu_w, glu_b, ctx_out):
    f32 = jnp.float32
    dtype = pl.dtype
    bmat = b_re.astype(f32) + 1j * b_im.astype(f32)
    group = lambda p: p.astype(f32).reshape(p.shape[0], p.shape[1], S5_NGROUPS, S5_GROUP)
    uc, ul = group(pc), group(pl)

    def make_scan(d):
        lam = jnp.minimum(a_re[d].astype(f32), S5_MAX_RE) + 1j * a_im[d].astype(f32)
        step = jnp.exp(log_dt[d].astype(f32))[:, None]
        abar = jnp.exp(lam * step)
        bbar = ((abar - 1.0) / lam)[:, :, None] * bmat
        cmat = c_re[d].astype(f32) + 1j * c_im[d].astype(f32)

        def scan(seq, h0):
            (u,) = seq
            bu = jnp.einsum('blgc,gnc->blgn', u.astype(jnp.complex64), bbar)
            bu = bu.at[:, 0].add(abar * h0)
            _, h = lax.associative_scan(_linear_recurrence_op, (jnp.broadcast_to(abar, bu.shape), bu), axis=1)
            return jnp.einsum('blgn,gcn->blgc', h, cmat).real, h[:, -1]
        return scan

    h0 = jnp.zeros((pl.shape[0], S5_NGROUPS, S5_STATE), jnp.complex64)
    yc, yl = _bidirectional_with_prefix(make_scan(0), make_scan(1), (uc,), (ul,), h0)
    dmat = d_skip.astype(f32).reshape(S5_NGROUPS, S5_GROUP)

    def finish(y, u):
        y = (y + dmat * u).reshape(u.shape[0], u.shape[1], S5_WIDTH).astype(dtype)
        y = jax.nn.gelu(y, approximate=False)
        return y * jax.nn.sigmoid(y @ glu_w + glu_b)

    out_c = finish(yc, uc) if ctx_out else None
    return out_c, finish(yl, ul)


def _peer(xn, w_q, sub_keys, u_tab, v_tab):
    shape = xn.shape
    xt = xn.reshape(-1, shape[-1])
    n_tok = xt.shape[0]
    q = (xt @ w_q).reshape(n_tok, PEER_HEADS, 2, PEER_DQ // 2)
    s1 = jnp.einsum('thd,hnd->thn', q[:, :, 0], sub_keys[0]).astype(jnp.float32)
    s2 = jnp.einsum('thd,hnd->thn', q[:, :, 1], sub_keys[1]).astype(jnp.float32)
    v1, i1 = lax.top_k(s1, PEER_TOPK)
    v2, i2 = lax.top_k(s2, PEER_TOPK)
    cand = (v1[..., :, None] + v2[..., None, :]).reshape(n_tok, PEER_HEADS, PEER_TOPK * PEER_TOPK)
    cidx = (i1[..., :, None] * PEER_KEYS + i2[..., None, :]).reshape(n_tok, PEER_HEADS, PEER_TOPK * PEER_TOPK)
    best, pos = lax.top_k(cand, PEER_TOPK)
    experts = jnp.take_along_axis(cidx, pos, axis=-1).reshape(n_tok, PEER_HEADS * PEER_TOPK)
    gates = jax.nn.softmax(best, axis=-1).reshape(n_tok, PEER_HEADS * PEER_TOPK).astype(xn.dtype)
    nb = n_tok // PEER_BLOCK

    def block(args):
        xb, eb, gb = args
        hid = jnp.einsum('td,tkd->tk', xb, u_tab[eb])
        return jnp.einsum('tk,tkd->td', gb * jax.nn.gelu(hid, approximate=False), v_tab[eb])

    out = lax.map(block, (xt.reshape(nb, PEER_BLOCK, shape[-1]),
                          experts.reshape(nb, PEER_BLOCK, -1),
                          gates.reshape(nb, PEER_BLOCK, -1)))
    return out.reshape(shape)


def setup_inputs(seed: int = 0) -> dict:
    key = jax.random.key(seed)
    ks = iter(jax.random.split(key, 48))
    f32 = jnp.float32
    nd = DEPTH

    def nrm(shape, scale):
        return jax.random.normal(next(ks), shape, f32) * scale

    def gain(shape):
        return 1.0 + nrm(shape, 0.02)

    def unif(shape, lo, hi):
        return jax.random.uniform(next(ks), shape, f32, lo, hi)

    x = nrm((BATCH, SEQ, D_MODEL), 1.0)
    c = nrm((BATCH, D_MODEL), 1.0)
    ctx = nrm((BATCH, CTX_LEN, D_MODEL), 1.0)
    c_ctx = nrm((D_MODEL,), 1.0)
    ada_w = nrm((nd, D_MODEL, N_MOD * D_MODEL), 0.5 * D_MODEL ** -0.5)
    ada_b = nrm((nd, N_MOD * D_MODEL), 0.02)
    norm_mix_g = gain((nd, D_MODEL))
    norm_ffn_g = gain((nd, D_MODEL))
    w_in = nrm((nd, D_MODEL, D_IN), D_MODEL ** -0.5)
    w_out = nrm((nd, D_MIX, D_MODEL), D_MIX ** -0.5)
    ssd_conv_w = nrm((nd, SSD_CONV, SSD_CONV_CH), SSD_CONV ** -0.5)
    ssd_conv_b = nrm((nd, SSD_CONV_CH), 0.02)
    ssd_a_log = jnp.log(unif((nd, 2, SSD_HEADS), 1.0, 16.0))
    dt0 = jnp.exp(unif((nd, 2, SSD_HEADS), math.log(1e-3), math.log(1e-1)))
    ssd_dt_bias = dt0 + jnp.log(-jnp.expm1(-dt0))
    ssd_d = 1.0 + nrm((nd, SSD_HEADS), 0.1)
    ssd_norm_g = gain((nd, SSD_WIDTH))
    gla_gate_w = nrm((nd, 2, GLA_GATE_RANK, GLA_QK), GLA_GATE_RANK ** -0.5)
    gla_gate_b = nrm((nd, 2, GLA_QK), 0.1)
    gla_norm_g = gain((nd, GLA_DV))
    mla_q_norm_g = gain((nd, MLA_Q_RANK))
    mla_w_uq = nrm((nd, MLA_Q_RANK, MLA_HEADS * (MLA_NOPE + MLA_ROPE)), MLA_Q_RANK ** -0.5)
    mla_kv_norm_g = gain((nd, MLA_KV_RANK))
    mla_w_ukv = nrm((nd, MLA_KV_RANK, MLA_HEADS * (MLA_NOPE + MLA_V)), MLA_KV_RANK ** -0.5)
    s5_a_re = -0.5 + nrm((nd, 2, S5_NGROUPS, S5_STATE), 0.01)
    s5_a_im = jnp.pi * jnp.arange(S5_STATE, dtype=f32) + nrm((nd, 2, S5_NGROUPS, S5_STATE), 0.01)
    s5_log_dt = unif((nd, 2, S5_NGROUPS), math.log(1e-3), math.log(1e-1))
    s5_b_re = nrm((nd, S5_NGROUPS, S5_STATE, S5_GROUP), (2 * S5_GROUP) ** -0.5)
    s5_b_im = nrm((nd, S5_NGROUPS, S5_STATE, S5_GROUP), (2 * S5_GROUP) ** -0.5)
    s5_c_re = nrm((nd, 2, S5_NGROUPS, S5_GROUP, S5_STATE), (2 * S5_STATE) ** -0.5)
    s5_c_im = nrm((nd, 2, S5_NGROUPS, S5_GROUP, S5_STATE), (2 * S5_STATE) ** -0.5)
    s5_d = nrm((nd, S5_WIDTH), 1.0)
    s5_glu_w = nrm((nd, S5_WIDTH, S5_WIDTH), S5_WIDTH ** -0.5)
    s5_glu_b = nrm((nd, S5_WIDTH), 0.02)
    peer_w_q = nrm((nd, D_MODEL, PEER_HEADS * PEER_DQ), D_MODEL ** -0.5)
    peer_sub_keys = nrm((nd, 2, PEER_HEADS, PEER_KEYS, PEER_DQ // 2), (PEER_DQ // 2) ** -0.5)
    peer_u = nrm((nd, PEER_EXPERTS, D_MODEL), D_MODEL ** -0.5)
    peer_v = nrm((nd, PEER_EXPERTS, D_MODEL), 1.0)
    final_norm_g = gain((D_MODEL,))
    return {'x': x, 'c': c, 'ctx': ctx, 'c_ctx': c_ctx, 'ada_w': ada_w, 'ada_b': ada_b,
            'norm_mix_g': norm_mix_g, 'norm_ffn_g': norm_ffn_g, 'w_in': w_in, 'w_out': w_out,
            'ssd_conv_w': ssd_conv_w, 'ssd_conv_b': ssd_conv_b, 'ssd_a_log': ssd_a_log,
            'ssd_dt_bias': ssd_dt_bias, 'ssd_d': ssd_d, 'ssd_norm_g': ssd_norm_g,
            'gla_gate_w': gla_gate_w, 'gla_gate_b': gla_gate_b, 'gla_norm_g': gla_norm_g,
            'mla_q_norm_g': mla_q_norm_g, 'mla_w_uq': mla_w_uq, 'mla_kv_norm_g': mla_kv_norm_g,
            'mla_w_ukv': mla_w_ukv, 's5_a_re': s5_a_re, 's5_a_im': s5_a_im, 's5_log_dt': s5_log_dt,
            's5_b_re': s5_b_re, 's5_b_im': s5_b_im, 's5_c_re': s5_c_re, 's5_c_im': s5_c_im,
            's5_d': s5_d, 's5_glu_w': s5_glu_w, 's5_glu_b': s5_glu_b, 'peer_w_q': peer_w_q,
            'peer_sub_keys': peer_sub_keys, 'peer_u': peer_u, 'peer_v': peer_v,
            'final_norm_g': final_norm_g}


def reference(x, c, ctx, c_ctx, ada_w, ada_b, norm_mix_g, norm_ffn_g, w_in, w_out,
              ssd_conv_w, ssd_conv_b, ssd_a_log, ssd_dt_bias, ssd_d, ssd_norm_g,
              gla_gate_w, gla_gate_b, gla_norm_g, mla_q_norm_g, mla_w_uq, mla_kv_norm_g, mla_w_ukv,
              s5_a_re, s5_a_im, s5_log_dt, s5_b_re, s5_b_im, s5_c_re, s5_c_im, s5_d, s5_glu_w, s5_glu_b,
              peer_w_q, peer_sub_keys, peer_u, peer_v, final_norm_g):
    h_lat, h_ctx = x, ctx
    cond_lat = jax.nn.silu(c)[:, None, :]
    cond_ctx = jax.nn.silu(c_ctx)[None, None, :]
    splits = (SSD_IN, GLA_IN, MLA_IN, S5_IN)
    for i in range(DEPTH):
        ctx_out = i < DEPTH - 1
        mod_l = jnp.split(cond_lat @ ada_w[i] + ada_b[i], N_MOD, axis=-1)
        mod_c = jnp.split(cond_ctx @ ada_w[i] + ada_b[i], N_MOD, axis=-1)
        p_l = _modulate(h_lat, norm_mix_g[i], mod_l[0], mod_l[1]) @ w_in[i]
        p_c = _modulate(h_ctx, norm_mix_g[i], mod_c[0], mod_c[1]) @ w_in[i]
        ssd_pl, gla_pl, mla_pl, s5_pl = _split(p_l, splits)
        ssd_pc, gla_pc, mla_pc, s5_pc = _split(p_c, splits)
        ssd_c, ssd_l = _ssd_mixer(ssd_pc, ssd_pl, ssd_conv_w[i], ssd_conv_b[i], ssd_a_log[i],
                                  ssd_dt_bias[i], ssd_d[i], ssd_norm_g[i], ctx_out)
        gla_c, gla_l = _gla_mixer(gla_pc, gla_pl, gla_gate_w[i], gla_gate_b[i], gla_norm_g[i], ctx_out)
        mla_c, mla_l = _mla_mixer(mla_pc, mla_pl, mla_q_norm_g[i], mla_w_uq[i], mla_kv_norm_g[i],
                                  mla_w_ukv[i], ctx_out)
        s5_c, s5_l = _s5_mixer(s5_pc, s5_pl, s5_a_re[i], s5_a_im[i], s5_log_dt[i], s5_b_re[i], s5_b_im[i],
                               s5_c_re[i], s5_c_im[i], s5_d[i], s5_glu_w[i], s5_glu_b[i], ctx_out)
        mix_l = jnp.concatenate([ssd_l, gla_l, mla_l, s5_l], axis=-1) @ w_out[i]
        h_lat = h_lat + mod_l[2] * mix_l
        f_l = _modulate(h_lat, norm_ffn_g[i], mod_l[3], mod_l[4])
        h_lat = h_lat + mod_l[5] * _peer(f_l, peer_w_q[i], peer_sub_keys[i], peer_u[i], peer_v[i])
        if ctx_out:
            mix_c = jnp.concatenate([ssd_c, gla_c, mla_c, s5_c], axis=-1) @ w_out[i]
            h_ctx = h_ctx + mod_c[2] * mix_c
            f_c = _modulate(h_ctx, norm_ffn_g[i], mod_c[3], mod_c[4])
            h_ctx = h_ctx + mod_c[5] * _peer(f_c, peer_w_q[i], peer_sub_keys[i], peer_u[i], peer_v[i])
    return _rmsnorm(h_lat, final_norm_g)
```

```cpp
#ifndef EMU
#include <hip/hip_runtime.h>
#endif
#include <stdint.h>
#include <stddef.h>

#ifndef SEQ_
#define SEQ_ 8192
#endif
#ifndef CTX_
#define CTX_ 256
#endif

#ifdef EMU
#define SMEM_DECL(name, bytes) char* name = emu_block_smem()
#define LAUNCH(kern, grid, block, stream, ...) emu_launch(dim3(grid), dim3(block), false, [=]() { kern(__VA_ARGS__); })
#else
#define SMEM_DECL(name, bytes) __shared__ __attribute__((aligned(16))) char name[bytes]
#define LAUNCH(kern, grid, block, stream, ...) hipLaunchKernelGGL(kern, dim3(grid), dim3(block), 0, stream, __VA_ARGS__)
#endif

namespace {
constexpr int DM = 1024, NB = 2, SEQ = SEQ_, CTX = CTX_, GRIDW = 64;
constexpr int NL = NB * SEQ, NC = NB * CTX, NT = NL + NC;
constexpr int DIN = 2504, NMOD = 6;
constexpr int O_SSD = 0, O_GLA = 1032, O_MLA = 1832, O_S5 = 2248;
constexpr float EPS = 1e-6f;

__device__ __forceinline__ float siluf(float x) { return x / (1.f + expf(-x)); }
__device__ __forceinline__ float sigmoidf_(float x) { return 1.f / (1.f + expf(-x)); }
__device__ __forceinline__ float softplusf(float x) { return x > 20.f ? x : log1pf(expf(x)); }
__device__ __forceinline__ float logsigmoidf(float x) { return -softplusf(-x); }
__device__ __forceinline__ float geluf(float x) { return 0.5f * x * (1.f + erff(x * 0.70710678118654752f)); }
__device__ __forceinline__ float wave_sum(float v) {
#pragma unroll
  for (int m = 32; m >= 1; m >>= 1) v += __shfl_xor(v, m);
  return v;
}
__device__ __forceinline__ int row_mod(int r) { return r < NL ? r / SEQ : 2; }

__global__ void k_mod(const float* c, const float* c_ctx, const float* ada_w, const float* ada_b, float* mod) {
  int idx = blockIdx.x * blockDim.x + threadIdx.x;
  if (idx >= 2 * 3 * NMOD * DM) return;
  int j = idx % (NMOD * DM); int m = (idx / (NMOD * DM)) % 3; int l = idx / (3 * NMOD * DM);
  const float* cv = m < 2 ? c + m * DM : c_ctx;
  const float* w = ada_w + (size_t)l * DM * NMOD * DM;
  float s = 0.f;
  for (int k = 0; k < DM; ++k) s += siluf(cv[k]) * w[(size_t)k * NMOD * DM + j];
  mod[idx] = s + ada_b[l * NMOD * DM + j];
}
__global__ void k_copy_h(const float* x, const float* ctx, float* H) {
  size_t i = (size_t)blockIdx.x * blockDim.x + threadIdx.x;
  if (i >= (size_t)NT * DM) return;
  H[i] = i < (size_t)NL * DM ? x[i] : ctx[i - (size_t)NL * DM];
}
__global__ void k_modulate(const float* H, const float* g, const float* mod, int ishift, int iscale, float* A, int nrows) {
  int wave = (blockIdx.x * blockDim.x + threadIdx.x) / 64, lane = threadIdx.x & 63;
  if (wave >= nrows) return;
  const float* h = H + (size_t)wave * DM;
  float ss = 0.f;
  for (int k = lane; k < DM; k += 64) ss += h[k] * h[k];
  ss = wave_sum(ss);
  float rs = rsqrtf(ss / DM + EPS);
  const float* mm = mod + row_mod(wave) * NMOD * DM;
  for (int k = lane; k < DM; k += 64)
    A[(size_t)wave * DM + k] = h[k] * rs * g[k] * (1.f + mm[iscale * DM + k]) + mm[ishift * DM + k];
}
__global__ void __launch_bounds__(256) k_gemm(const float* A, int lda, const float* W, int ldw, float* C, int ldc, int M, int N, int K) {
  SMEM_DECL(smem, 2 * 16 * 68 * 4);
  float (*As)[68] = (float (*)[68])smem;
  float (*Bs)[68] = (float (*)[68])(smem + 16 * 68 * 4);
  int tid = threadIdx.x, tx = tid & 15, ty = tid >> 4;
  int m0 = blockIdx.y * 64, n0 = blockIdx.x * 64;
  float acc[4][4];
#pragma unroll
  for (int i = 0; i < 4; ++i)
#pragma unroll
    for (int j = 0; j < 4; ++j) acc[i][j] = 0.f;
  for (int k0 = 0; k0 < K; k0 += 16) {
    {
      int r = tid >> 2, kk = (tid & 3) * 4;
#pragma unroll
      for (int j = 0; j < 4; ++j) {
        int row = m0 + r;
        As[kk + j][r] = (row < M) ? A[(size_t)row * lda + k0 + kk + j] : 0.f;
      }
      int kr = tid >> 4, nn = (tid & 15) * 4;
#pragma unroll
      for (int j = 0; j < 4; ++j) {
        int col = n0 + nn + j;
        Bs[kr][nn + j] = (col < N) ? W[(size_t)(k0 + kr) * ldw + col] : 0.f;
      }
    }
    __syncthreads();
#pragma unroll
    for (int k = 0; k < 16; ++k) {
      float a[4], b[4];
#pragma unroll
      for (int i = 0; i < 4; ++i) a[i] = As[k][ty * 4 + i];
#pragma unroll
      for (int j = 0; j < 4; ++j) b[j] = Bs[k][tx * 4 + j];
#pragma unroll
      for (int i = 0; i < 4; ++i)
#pragma unroll
        for (int j = 0; j < 4; ++j) acc[i][j] += a[i] * b[j];
    }
    __syncthreads();
  }
#pragma unroll
  for (int i = 0; i < 4; ++i)
#pragma unroll
    for (int j = 0; j < 4; ++j) {
      int row = m0 + ty * 4 + i, col = n0 + tx * 4 + j;
      if (row < M && col < N) C[(size_t)row * ldc + col] = acc[i][j];
    }
}
__global__ void k_ssd_prep(const float* P, const float* conv_w, const float* conv_b, const float* dt_bias, float* XBC, float* DT) {
  size_t idx = (size_t)blockIdx.x * blockDim.x + threadIdx.x;
  if (idx >= (size_t)NT * 776) return;
  int r = (int)(idx / 776), c = (int)(idx % 776);
  if (c < 768) {
    int t, len, base;
    if (r < NL) { t = r % SEQ; len = SEQ; base = r - t; } else { t = (r - NL) % CTX; len = CTX; base = r - t; }
    float s = conv_b[c];
#pragma unroll
    for (int k = 0; k < 5; ++k) {
      int tt = t + k - 2;
      if (tt >= 0 && tt < len) s += conv_w[k * 768 + c] * P[(size_t)(base + tt) * DIN + O_SSD + 256 + c];
    }
    XBC[(size_t)r * 768 + c] = siluf(s);
  } else {
    int j = c - 768;
    DT[(size_t)r * 8 + j] = softplusf(P[(size_t)r * DIN + O_SSD + 1024 + j] + dt_bias[j]);
  }
}
__global__ void __launch_bounds__(256) k_ssd_scan(const float* XBC, const float* DT, const float* a_log, float* CAT, int dir) {
  int b = blockIdx.x / 4, h = blockIdx.x % 4, tid = threadIdx.x, p = tid >> 2, q = tid & 3;
  float a_head = -expf(a_log[dir * 4 + h]);
  int grp = h >> 1;
  float st[32];
#pragma unroll
  for (int i = 0; i < 32; ++i) st[i] = 0.f;
  for (int s = 0; s < CTX + SEQ; ++s) {
    int r;
    if (s < CTX) r = NL + b * CTX + (dir ? CTX - 1 - s : s);
    else { int t = s - CTX; r = b * SEQ + (dir ? SEQ - 1 - t : t); }
    float dt = DT[(size_t)r * 8 + dir * 4 + h];
    float g = expf(dt * a_head);
    const float* xr = XBC + (size_t)r * 768;
    float xd = xr[h * 64 + p] * dt;
    const float* Bm = xr + 256 + grp * 128 + q * 32;
    const float* Cm = xr + 512 + grp * 128 + q * 32;
    float y = 0.f;
#pragma unroll
    for (int i = 0; i < 32; ++i) { st[i] = g * st[i] + xd * Bm[i]; y += st[i] * Cm[i]; }
    y += __shfl_xor(y, 1); y += __shfl_xor(y, 2);
    if (q == 0) { float* o = CAT + (size_t)r * DM + h * 64 + p; if (dir) *o += y; else *o = y; }
  }
}
__global__ void k_ssd_finish(const float* P, const float* XBC, const float* d_skip, const float* norm_g, float* CAT, int nrows) {
  int row = (blockIdx.x * blockDim.x + threadIdx.x) / 64, lane = threadIdx.x & 63;
  if (row >= nrows) return;
  float v[4]; float ss = 0.f;
#pragma unroll
  for (int i = 0; i < 4; ++i) {
    int c = lane + 64 * i, h = c >> 6;
    float y = CAT[(size_t)row * DM + c] + d_skip[h] * XBC[(size_t)row * 768 + c];
    y *= siluf(P[(size_t)row * DIN + O_SSD + c]);
    v[i] = y; ss += y * y;
  }
  ss = wave_sum(ss);
  float rs = rsqrtf(ss / 256.f + EPS);
#pragma unroll
  for (int i = 0; i < 4; ++i) { int c = lane + 64 * i; CAT[(size_t)row * DM + c] = v[i] * rs * norm_g[c]; }
}
__global__ void k_gla_prep(const float* P, const float* gate_w, const float* gate_b, float* LOGG) {
  size_t idx = (size_t)blockIdx.x * blockDim.x + threadIdx.x;
  if (idx >= (size_t)NT * 256) return;
  int r = (int)(idx >> 8), d = (int)((idx >> 7) & 1), j = (int)(idx & 127);
  float s = gate_b[d * 128 + j];
  for (int k = 0; k < 16; ++k) s += P[(size_t)r * DIN + O_GLA + 768 + d * 16 + k] * gate_w[(d * 16 + k) * 128 + j];
  LOGG[idx] = logsigmoidf(s) * (1.f / 16.f);
}
__global__ void __launch_bounds__(64) k_gla_scan(const float* P, const float* LOGG, float* CAT, int dir) {
  int b = blockIdx.x / 4, h = blockIdx.x % 4, dv = threadIdx.x;
  float S[32];
#pragma unroll
  for (int i = 0; i < 32; ++i) S[i] = 0.f;
  const float qs = 0.17677669529663687f;
  for (int s = 0; s < CTX + SEQ; ++s) {
    int r;
    if (s < CTX) r = NL + b * CTX + (dir ? CTX - 1 - s : s);
    else { int t = s - CTX; r = b * SEQ + (dir ? SEQ - 1 - t : t); }
    const float* pr = P + (size_t)r * DIN + O_GLA;
    const float* lg = LOGG + (size_t)r * 256 + dir * 128 + h * 32;
    float v = pr[256 + h * 64 + dv];
    float o = 0.f;
#pragma unroll
    for (int i = 0; i < 32; ++i) {
      S[i] = expf(lg[i]) * S[i] + pr[128 + h * 32 + i] * v;
      o += pr[h * 32 + i] * qs * S[i];
    }
    float* op = CAT + (size_t)r * DM + 256 + h * 64 + dv;
    if (dir) *op += o; else *op = o;
  }
}
__global__ void k_gla_finish(const float* P, const float* norm_g, float* CAT, int nrows) {
  int w = (blockIdx.x * blockDim.x + threadIdx.x) / 64, lane = threadIdx.x & 63;
  if (w >= nrows * 4) return;
  int row = w >> 2, h = w & 3;
  float* op = CAT + (size_t)row * DM + 256 + h * 64 + lane;
  float o = *op;
  float ss = wave_sum(o * o);
  float rs = rsqrtf(ss / 64.f + EPS);
  *op = o * rs * norm_g[lane] * siluf(P[(size_t)row * DIN + O_GLA + 512 + h * 64 + lane]);
}
__global__ void k_mla_norm(const float* P, const float* qg, const float* kvg, float* NQ, float* NKV) {
  int row = (blockIdx.x * blockDim.x + threadIdx.x) / 64, lane = threadIdx.x & 63;
  if (row >= NT) return;
  const float* pr = P + (size_t)row * DIN + O_MLA;
  float v[4], ss = 0.f;
#pragma unroll
  for (int i = 0; i < 4; ++i) { v[i] = pr[lane + 64 * i]; ss += v[i] * v[i]; }
  ss = wave_sum(ss);
  float rs = rsqrtf(ss / 256.f + EPS);
#pragma unroll
  for (int i = 0; i < 4; ++i) NQ[(size_t)row * 256 + lane + 64 * i] = v[i] * rs * qg[lane + 64 * i];
  float u[2]; ss = 0.f;
#pragma unroll
  for (int i = 0; i < 2; ++i) { u[i] = pr[256 + lane + 64 * i]; ss += u[i] * u[i]; }
  ss = wave_sum(ss);
  rs = rsqrtf(ss / 128.f + EPS);
#pragma unroll
  for (int i = 0; i < 2; ++i) NKV[(size_t)row * 128 + lane + 64 * i] = u[i] * rs * kvg[lane + 64 * i];
}
__global__ void k_mla_rope(const float* P, float* Q, const float* KVraw, float* K, float* V) {
  size_t idx = (size_t)blockIdx.x * blockDim.x + threadIdx.x;
  if (idx >= (size_t)NT * 4 * 16) return;
  int r = (int)(idx / 64), h = (int)((idx / 16) % 4), i = (int)(idx % 16);
  float cs = 1.f, sn = 0.f;
  if (r < NL) {
    int t = r % SEQ; int rowi = t / GRIDW, coli = t % GRIDW;
    int f = i & 7;
    float inv = powf(10000.f, -(float)(2 * f) / 16.f);
    float ang = (i < 8 ? (float)rowi : (float)coli) * inv;
    cs = cosf(ang); sn = sinf(ang);
  }
  float* q = Q + (size_t)r * 384 + h * 96 + 64;
  float x1 = q[i], x2 = q[i + 16];
  q[i] = x1 * cs - x2 * sn; q[i + 16] = x1 * sn + x2 * cs;
  const float* kr = P + (size_t)r * DIN + O_MLA + 384;
  float k1 = kr[i], k2 = kr[i + 16];
  float* kk = K + (size_t)r * 384 + h * 96;
  kk[64 + i] = k1 * cs - k2 * sn; kk[64 + 16 + i] = k1 * sn + k2 * cs;
  const float* kv = KVraw + (size_t)r * 512 + h * 128;
  for (int j = i; j < 64; j += 16) { kk[j] = kv[j]; V[(size_t)r * 256 + h * 64 + j] = kv[64 + j]; }
}
__global__ void __launch_bounds__(64) k_attn(const float* Q, const float* K, const float* V, float* CAT, int row0, int nrows) {
  int h = blockIdx.y; int r = row0 + blockIdx.x * 64 + threadIdx.x;
  if (r >= row0 + nrows) return;
  float q[96], o[64];
  const float scale = 0.10206207261596575f;
#pragma unroll
  for (int i = 0; i < 96; ++i) q[i] = Q[(size_t)r * 384 + h * 96 + i] * scale;
#pragma unroll
  for (int i = 0; i < 64; ++i) o[i] = 0.f;
  float m = -1e30f, l = 0.f;
  int b, nseg; int seg0[2], segn[2];
  if (r < NL) { b = r / SEQ; nseg = 2; seg0[0] = b * SEQ; segn[0] = SEQ; seg0[1] = NL + b * CTX; segn[1] = CTX; }
  else { b = (r - NL) / CTX; nseg = 1; seg0[0] = NL + b * CTX; segn[0] = CTX; seg0[1] = 0; segn[1] = 0; }
  for (int sg = 0; sg < nseg; ++sg)
    for (int j = 0; j < segn[sg]; ++j) {
      const float* kp = K + (size_t)(seg0[sg] + j) * 384 + h * 96;
      const float* vp = V + (size_t)(seg0[sg] + j) * 256 + h * 64;
      float s = 0.f;
#pragma unroll
      for (int i = 0; i < 96; ++i) s += q[i] * kp[i];
      float mn = fmaxf(m, s);
      float al = expf(m - mn), pp = expf(s - mn);
      l = l * al + pp;
#pragma unroll
      for (int i = 0; i < 64; ++i) o[i] = o[i] * al + pp * vp[i];
      m = mn;
    }
  float il = 1.f / l;
#pragma unroll
  for (int i = 0; i < 64; ++i) CAT[(size_t)r * DM + 512 + h * 64 + i] = o[i] * il;
}
__global__ void __launch_bounds__(64) k_s5_scan(const float* P, const float* a_re, const float* a_im, const float* log_dt,
                                                const float* b_re, const float* b_im, const float* c_re, const float* c_im,
                                                float* CAT, int dir) {
  int b = blockIdx.x / 16, g = blockIdx.x % 16, n = threadIdx.x;
  float lre = fminf(a_re[(dir * 16 + g) * 64 + n], -1e-4f), lim = a_im[(dir * 16 + g) * 64 + n];
  float step = expf(log_dt[dir * 16 + g]);
  float er = expf(lre * step);
  float ar = er * cosf(lim * step), ai = er * sinf(lim * step);
  float nr = ar - 1.f, ni = ai, den = lre * lre + lim * lim;
  float cr = (nr * lre + ni * lim) / den, ci = (ni * lre - nr * lim) / den;
  float bbr[16], bbi[16], cmr[16], cmi[16];
#pragma unroll
  for (int c = 0; c < 16; ++c) {
    float br = b_re[(g * 64 + n) * 16 + c], bi = b_im[(g * 64 + n) * 16 + c];
    bbr[c] = cr * br - ci * bi; bbi[c] = cr * bi + ci * br;
    cmr[c] = c_re[((dir * 16 + g) * 16 + c) * 64 + n]; cmi[c] = c_im[((dir * 16 + g) * 16 + c) * 64 + n];
  }
  float hr = 0.f, hi = 0.f;
  for (int s = 0; s < CTX + SEQ; ++s) {
    int r;
    if (s < CTX) r = NL + b * CTX + (dir ? CTX - 1 - s : s);
    else { int t = s - CTX; r = b * SEQ + (dir ? SEQ - 1 - t : t); }
    const float* u = P + (size_t)r * DIN + O_S5 + g * 16;
    float bur = 0.f, bui = 0.f;
#pragma unroll
    for (int c = 0; c < 16; ++c) { float uc = u[c]; bur += uc * bbr[c]; bui += uc * bbi[c]; }
    float nhr = ar * hr - ai * hi + bur, nhi = ar * hi + ai * hr + bui;
    hr = nhr; hi = nhi;
    float yv = 0.f;
#pragma unroll
    for (int c = 0; c < 16; ++c) {
      float y = wave_sum(hr * cmr[c] - hi * cmi[c]);
      if (n == c) yv = y;
    }
    if (n < 16) { float* o = CAT + (size_t)r * DM + 768 + g * 16 + n; if (dir) *o += yv; else *o = yv; }
  }
}
__global__ void k_s5_gelu(const float* P, const float* d_skip, float* CAT, int nrows) {
  size_t idx = (size_t)blockIdx.x * blockDim.x + threadIdx.x;
  if (idx >= (size_t)nrows * 256) return;
  int r = (int)(idx >> 8), c = (int)(idx & 255);
  float* o = CAT + (size_t)r * DM + 768 + c;
  *o = geluf(*o + d_skip[c] * P[(size_t)r * DIN + O_S5 + c]);
}
__global__ void k_s5_glu(const float* T, const float* glu_b, float* CAT, int nrows) {
  size_t idx = (size_t)blockIdx.x * blockDim.x + threadIdx.x;
  if (idx >= (size_t)nrows * 256) return;
  int r = (int)(idx >> 8), c = (int)(idx & 255);
  float* o = CAT + (size_t)r * DM + 768 + c;
  *o = *o * sigmoidf_(T[idx] + glu_b[c]);
}
__global__ void k_resid(float* H, const float* X, const float* mod, int imod, int nrows) {
  size_t idx = (size_t)blockIdx.x * blockDim.x + threadIdx.x;
  if (idx >= (size_t)nrows * DM) return;
  int r = (int)(idx >> 10), c = (int)(idx & 1023);
  H[idx] += mod[row_mod(r) * NMOD * DM + imod * DM + c] * X[idx];
}
__global__ void __launch_bounds__(128) k_peer_topk(const float* QP, const float* sub_keys, int* EIDX, float* GATE) {
  SMEM_DECL(smem, 4096);
  float* s1 = (float*)smem; float* s2 = s1 + 128; float* v1 = s2 + 128; float* v2 = v1 + 16;
  int* i1 = (int*)(v2 + 16); int* i2 = i1 + 16; float* cand = (float*)(i2 + 16); float* best = cand + 256; int* bidx = (int*)(best + 16);
  int row = blockIdx.x, h = blockIdx.y, j = threadIdx.x;
  const float* q = QP + (size_t)row * DM + h * 128;
  const float* k1 = sub_keys + ((size_t)(0 * 8 + h) * 128 + j) * 64;
  const float* k2 = sub_keys + ((size_t)(1 * 8 + h) * 128 + j) * 64;
  float a = 0.f, b = 0.f;
  for (int d = 0; d < 64; ++d) { a += q[d] * k1[d]; b += q[64 + d] * k2[d]; }
  s1[j] = a; s2[j] = b;
  __syncthreads();
  int ra = 0, rb = 0;
  for (int i = 0; i < 128; ++i) {
    float x = s1[i], y = s2[i];
    ra += (x > a) || (x == a && i < j);
    rb += (y > b) || (y == b && i < j);
  }
  if (ra < 16) { v1[ra] = a; i1[ra] = j; }
  if (rb < 16) { v2[rb] = b; i2[rb] = j; }
  __syncthreads();
  float c0 = v1[j >> 4] + v2[j & 15], c1 = v1[(j + 128) >> 4] + v2[(j + 128) & 15];
  cand[j] = c0; cand[j + 128] = c1;
  __syncthreads();
  int r0 = 0, r1 = 0;
  for (int i = 0; i < 256; ++i) {
    float x = cand[i];
    r0 += (x > c0) || (x == c0 && i < j);
    r1 += (x > c1) || (x == c1 && i < j + 128);
  }
  if (r0 < 16) { best[r0] = c0; bidx[r0] = i1[j >> 4] * 128 + i2[j & 15]; }
  if (r1 < 16) { best[r1] = c1; bidx[r1] = i1[(j + 128) >> 4] * 128 + i2[(j + 128) & 15]; }
  __syncthreads();
  if (j < 16) {
    float mx = best[0];
    float sum = 0.f;
    for (int i = 0; i < 16; ++i) sum += expf(best[i] - mx);
    GATE[(size_t)row * 128 + h * 16 + j] = expf(best[j] - mx) / sum;
    EIDX[(size_t)row * 128 + h * 16 + j] = bidx[j];
  }
}
__global__ void __launch_bounds__(256) k_peer_gather(const float* F, const int* EIDX, const float* GATE, const float* U, const float* Vt,
                                                     const float* mod, float* H) {
  SMEM_DECL(smem, 8192);
  float* f = (float*)smem; float* wgt = f + 1024; int* eid = (int*)(wgt + 128);
  int row = blockIdx.x, tid = threadIdx.x, lane = tid & 63, w = tid >> 6;
  for (int i = tid; i < 1024; i += 256) f[i] = F[(size_t)row * DM + i];
  if (tid < 128) eid[tid] = EIDX[(size_t)row * 128 + tid];
  __syncthreads();
  for (int kk = 0; kk < 32; ++kk) {
    int k = w * 32 + kk; const float* u = U + (size_t)eid[k] * DM;
    float s = 0.f;
#pragma unroll
    for (int i = 0; i < 16; ++i) s += f[lane + 64 * i] * u[lane + 64 * i];
    s = wave_sum(s);
    if (lane == 0) wgt[k] = GATE[(size_t)row * 128 + k] * geluf(s);
  }
  __syncthreads();
  float acc[4] = {0.f, 0.f, 0.f, 0.f};
  for (int k = 0; k < 128; ++k) {
    const float* v = Vt + (size_t)eid[k] * DM; float wk = wgt[k];
#pragma unroll
    for (int i = 0; i < 4; ++i) acc[i] += wk * v[tid + 256 * i];
  }
  const float* mm = mod + row_mod(row) * NMOD * DM + 5 * DM;
#pragma unroll
  for (int i = 0; i < 4; ++i) { int c = tid + 256 * i; H[(size_t)row * DM + c] += mm[c] * acc[i]; }
}
__global__ void k_final(const float* H, const float* g, float* out) {
  int row = (blockIdx.x * blockDim.x + threadIdx.x) / 64, lane = threadIdx.x & 63;
  if (row >= NL) return;
  const float* h = H + (size_t)row * DM;
  float ss = 0.f;
  for (int k = lane; k < DM; k += 64) ss += h[k] * h[k];
  ss = wave_sum(ss);
  float rs = rsqrtf(ss / DM + EPS);
  for (int k = lane; k < DM; k += 64) out[(size_t)row * DM + k] = h[k] * rs * g[k];
}
}

static inline int cdiv(size_t a, size_t b) { return (int)((a + b - 1) / b); }

extern "C" void kernel_launch(void* const* d_in, const int* in_sizes, int n_in, void* d_out, int out_size, void* d_ws,
                              size_t ws_size, hipStream_t stream) {
  const float* x = (const float*)d_in[0];       const float* c = (const float*)d_in[1];
  const float* ctx = (const float*)d_in[2];     const float* c_ctx = (const float*)d_in[3];
  const float* ada_w = (const float*)d_in[4];   const float* ada_b = (const float*)d_in[5];
  const float* norm_mix_g = (const float*)d_in[6]; const float* norm_ffn_g = (const float*)d_in[7];
  const float* w_in = (const float*)d_in[8];    const float* w_out = (const float*)d_in[9];
  const float* ssd_conv_w = (const float*)d_in[10]; const float* ssd_conv_b = (const float*)d_in[11];
  const float* ssd_a_log = (const float*)d_in[12];  const float* ssd_dt_bias = (const float*)d_in[13];
  const float* ssd_d = (const float*)d_in[14];  const float* ssd_norm_g = (const float*)d_in[15];
  const float* gla_gate_w = (const float*)d_in[16]; const float* gla_gate_b = (const float*)d_in[17];
  const float* gla_norm_g = (const float*)d_in[18]; const float* mla_q_norm_g = (const float*)d_in[19];
  const float* mla_w_uq = (const float*)d_in[20];   const float* mla_kv_norm_g = (const float*)d_in[21];
  const float* mla_w_ukv = (const float*)d_in[22];  const float* s5_a_re = (const float*)d_in[23];
  const float* s5_a_im = (const float*)d_in[24];    const float* s5_log_dt = (const float*)d_in[25];
  const float* s5_b_re = (const float*)d_in[26];    const float* s5_b_im = (const float*)d_in[27];
  const float* s5_c_re = (const float*)d_in[28];    const float* s5_c_im = (const float*)d_in[29];
  const float* s5_d = (const float*)d_in[30];       const float* s5_glu_w = (const float*)d_in[31];
  const float* s5_glu_b = (const float*)d_in[32];   const float* peer_w_q = (const float*)d_in[33];
  const float* peer_sub_keys = (const float*)d_in[34]; const float* peer_u = (const float*)d_in[35];
  const float* peer_v = (const float*)d_in[36];     const float* final_norm_g = (const float*)d_in[37];
  float* out = (float*)d_out;

  char* wp = (char*)d_ws; size_t off = 0;
  auto carve = [&](size_t nfloats) { float* p = (float*)(wp + off); off += ((nfloats * 4 + 255) / 256) * 256; return p; };
  float* MOD = carve(2 * 3 * NMOD * DM);
  float* H = carve((size_t)NT * DM);
  float* P = carve((size_t)NT * DIN);
  float* R2 = carve((size_t)NT * DM);
  float* CAT = carve((size_t)NT * DM);
  float* LOGG = carve((size_t)NT * 256);
  float* Q = carve((size_t)NT * 384);
  float* K = carve((size_t)NT * 384);
  float* V = carve((size_t)NT * 256);
  float* DT = carve((size_t)NT * 8);
  float* SCR = carve((size_t)NT * (256 + 128 + 512));
  if (off > ws_size) return;
  float* A = R2; float* XBC = R2;
  float* MIX = P; float* F = P + (size_t)NT * DM; float* QP = P;
  float* NQ = SCR; float* NKV = SCR + (size_t)NT * 256; float* KVraw = NKV + (size_t)NT * 128;
  float* T = SCR; int* EIDX = (int*)SCR; float* GATE = SCR + (size_t)NT * 128;

  LAUNCH(k_mod, cdiv(2 * 3 * NMOD * DM, 256), 256, stream, c, c_ctx, ada_w, ada_b, MOD);
  LAUNCH(k_copy_h, cdiv((size_t)NT * DM, 256), 256, stream, x, ctx, H);
  for (int l = 0; l < 2; ++l) {
    const float* mod = MOD + (size_t)l * 3 * NMOD * DM;
    const int nact = (l == 0) ? NT : NL;
    LAUNCH(k_modulate, cdiv((size_t)NT * 64, 256), 256, stream, (const float*)H, norm_mix_g + l * DM, mod, 0, 1, A, NT);
    LAUNCH(k_gemm, dim3(cdiv(DIN, 64), NT / 64), 256, stream, (const float*)A, DM, w_in + (size_t)l * DM * DIN, DIN, P, DIN, NT, DIN, DM);
    LAUNCH(k_ssd_prep, cdiv((size_t)NT * 776, 256), 256, stream, (const float*)P, ssd_conv_w + l * 5 * 768, ssd_conv_b + l * 768,
           ssd_dt_bias + l * 8, XBC, DT);
    for (int d = 0; d < 2; ++d)
      LAUNCH(k_ssd_scan, NB * 4, 256, stream, (const float*)XBC, (const float*)DT, ssd_a_log + l * 8, CAT, d);
    LAUNCH(k_ssd_finish, cdiv((size_t)nact * 64, 256), 256, stream, (const float*)P, (const float*)XBC, ssd_d + l * 4, ssd_norm_g + l * 256, CAT, nact);
    LAUNCH(k_gla_prep, cdiv((size_t)NT * 256, 256), 256, stream, (const float*)P, gla_gate_w + l * 2 * 16 * 128, gla_gate_b + l * 256, LOGG);
    for (int d = 0; d < 2; ++d) LAUNCH(k_gla_scan, NB * 4, 64, stream, (const float*)P, (const float*)LOGG, CAT, d);
    LAUNCH(k_gla_finish, cdiv((size_t)nact * 4 * 64, 256), 256, stream, (const float*)P, gla_norm_g + l * 64, CAT, nact);
    LAUNCH(k_mla_norm, cdiv((size_t)NT * 64, 256), 256, stream, (const float*)P, mla_q_norm_g + l * 256, mla_kv_norm_g + l * 128, NQ, NKV);
    LAUNCH(k_gemm, dim3(cdiv(384, 64), NT / 64), 256, stream, (const float*)NQ, 256, mla_w_uq + (size_t)l * 256 * 384, 384, Q, 384, NT, 384, 256);
    LAUNCH(k_gemm, dim3(cdiv(512, 64), NT / 64), 256, stream, (const float*)NKV, 128, mla_w_ukv + (size_t)l * 128 * 512, 512, KVraw, 512, NT, 512, 128);
    LAUNCH(k_mla_rope, cdiv((size_t)NT * 64, 256), 256, stream, (const float*)P, Q, (const float*)KVraw, K, V);
    LAUNCH(k_attn, dim3(cdiv(nact, 64), 4), 64, stream, (const float*)Q, (const float*)K, (const float*)V, CAT, 0, nact);
    for (int d = 0; d < 2; ++d)
      LAUNCH(k_s5_scan, NB * 16, 64, stream, (const float*)P, s5_a_re + l * 2048, s5_a_im + l * 2048, s5_log_dt + l * 32,
             s5_b_re + l * 16384, s5_b_im + l * 16384, s5_c_re + l * 32768, s5_c_im + l * 32768, CAT, d);
    LAUNCH(k_s5_gelu, cdiv((size_t)nact * 256, 256), 256, stream, (const float*)P, s5_d + l * 256, CAT, nact);
    LAUNCH(k_gemm, dim3(4, nact / 64), 256, stream, (const float*)(CAT + 768), DM, s5_glu_w + (size_t)l * 65536, 256, T, 256, nact, 256, 256);
    LAUNCH(k_s5_glu, cdiv((size_t)nact * 256, 256), 256, stream, (const float*)T, s5_glu_b + l * 256, CAT, nact);
    LAUNCH(k_gemm, dim3(DM / 64, nact / 64), 256, stream, (const float*)CAT, DM, w_out + (size_t)l * DM * DM, DM, MIX, DM, nact, DM, DM);
    LAUNCH(k_resid, cdiv((size_t)nact * DM, 256), 256, stream, H, (const float*)MIX, mod, 2, nact);
    LAUNCH(k_modulate, cdiv((size_t)nact * 64, 256), 256, stream, (const float*)H, norm_ffn_g + l * DM, mod, 3, 4, F, nact);
    LAUNCH(k_gemm, dim3(DM / 64, nact / 64), 256, stream, (const float*)F, DM, peer_w_q + (size_t)l * DM * DM, DM, QP, DM, nact, DM, DM);
    LAUNCH(k_peer_topk, dim3(nact, 8), 128, stream, (const float*)QP, peer_sub_keys + (size_t)l * 2 * 8 * 128 * 64, EIDX, GATE);
    LAUNCH(k_peer_gather, nact, 256, stream, (const float*)F, (const int*)EIDX, (const float*)GATE, peer_u + (size_t)l * 16384 * DM,
           peer_v + (size_t)l * 16384 * DM, mod, H);
  }
  LAUNCH(k_final, cdiv((size_t)NL * 64, 256), 256, stream, (const float*)H, final_norm_g, out);
}
```

```cpp
#ifndef EMU
#include <hip/hip_runtime.h>
#include <hip/hip_cooperative_groups.h>
#include <cstdio>
#endif
#include <stdint.h>
#include <stddef.h>

#ifndef SEQ_
#define SEQ_ 8192
#endif
#ifndef CTX_
#define CTX_ 256
#endif

#ifdef EMU
#define GRID_SYNC() emu_grid_sync()
#else
#define GRID_SYNC() cooperative_groups::this_grid().sync()
#endif

namespace {
constexpr int DM = 1024, NB = 2, SEQ = SEQ_, CTX = CTX_, GRIDW = 64;
constexpr int NL = NB * SEQ, NC = NB * CTX, NT = NL + NC;
constexpr int DIN = 2504, NMOD = 6;
constexpr int O_SSD = 0, O_GLA = 1032, O_MLA = 1832, O_S5 = 2248;
constexpr float EPS = 1e-6f;

__device__ __forceinline__ float siluf(float x) { return x / (1.f + expf(-x)); }
__device__ __forceinline__ float sigmoidf_(float x) { return 1.f / (1.f + expf(-x)); }
__device__ __forceinline__ float softplusf(float x) { return x > 20.f ? x : log1pf(expf(x)); }
__device__ __forceinline__ float logsigmoidf(float x) { return -softplusf(-x); }
__device__ __forceinline__ float geluf(float x) { return 0.5f * x * (1.f + erff(x * 0.70710678118654752f)); }
__device__ __forceinline__ float wave_sum(float v) {
#pragma unroll
  for (int m = 32; m >= 1; m >>= 1) v += __shfl_xor(v, m);
  return v;
}
__device__ __forceinline__ int row_mod(int r) { return r < NL ? r / SEQ : 2; }

__device__ __forceinline__ void d_mod(int vb, int tidp, char* smem, const float* c, const float* c_ctx, const float* ada_w, const float* ada_b, float* mod) {
  int idx = vb * 256 + tidp;
  if (idx >= 2 * 3 * NMOD * DM) return;
  int j = idx % (NMOD * DM); int m = (idx / (NMOD * DM)) % 3; int l = idx / (3 * NMOD * DM);
  const float* cv = m < 2 ? c + m * DM : c_ctx;
  const float* w = ada_w + (size_t)l * DM * NMOD * DM;
  float s = 0.f;
  for (int k = 0; k < DM; ++k) s += siluf(cv[k]) * w[(size_t)k * NMOD * DM + j];
  mod[idx] = s + ada_b[l * NMOD * DM + j];
}
__device__ __forceinline__ void d_copy_h(int vb, int tidp, char* smem, const float* x, const float* ctx, float* H) {
  size_t i = (size_t)vb * 256 + tidp;
  if (i >= (size_t)NT * DM) return;
  H[i] = i < (size_t)NL * DM ? x[i] : ctx[i - (size_t)NL * DM];
}
__device__ __forceinline__ void d_modulate(int vb, int tidp, char* smem, const float* H, const float* g, const float* mod, int ishift, int iscale, float* A, int nrows) {
  int wave = (vb * 256 + tidp) / 64, lane = tidp & 63;
  if (wave >= nrows) return;
  const float* h = H + (size_t)wave * DM;
  float ss = 0.f;
  for (int k = lane; k < DM; k += 64) ss += h[k] * h[k];
  ss = wave_sum(ss);
  float rs = rsqrtf(ss / DM + EPS);
  const float* mm = mod + row_mod(wave) * NMOD * DM;
  for (int k = lane; k < DM; k += 64)
    A[(size_t)wave * DM + k] = h[k] * rs * g[k] * (1.f + mm[iscale * DM + k]) + mm[ishift * DM + k];
}
__device__ __forceinline__ void d_gemm(int vb, int tidp, char* smem, const float* A, int lda, const float* W, int ldw, float* C, int ldc, int M, int N, int K) {
  float (*As)[68] = (float (*)[68])smem;
  float (*Bs)[68] = (float (*)[68])(smem + 16 * 68 * 4);
  int tid = tidp, tx = tid & 15, ty = tid >> 4;
  int nbx = (N + 63) / 64; int m0 = (vb / nbx) * 64, n0 = (vb % nbx) * 64;
  float acc[4][4];
#pragma unroll
  for (int i = 0; i < 4; ++i)
#pragma unroll
    for (int j = 0; j < 4; ++j) acc[i][j] = 0.f;
  for (int k0 = 0; k0 < K; k0 += 16) {
    {
      int r = tid >> 2, kk = (tid & 3) * 4;
#pragma unroll
      for (int j = 0; j < 4; ++j) {
        int row = m0 + r;
        As[kk + j][r] = (row < M) ? A[(size_t)row * lda + k0 + kk + j] : 0.f;
      }
      int kr = tid >> 4, nn = (tid & 15) * 4;
#pragma unroll
      for (int j = 0; j < 4; ++j) {
        int col = n0 + nn + j;
        Bs[kr][nn + j] = (col < N) ? W[(size_t)(k0 + kr) * ldw + col] : 0.f;
      }
    }
    __syncthreads();
#pragma unroll
    for (int k = 0; k < 16; ++k) {
      float a[4], b[4];
#pragma unroll
      for (int i = 0; i < 4; ++i) a[i] = As[k][ty * 4 + i];
#pragma unroll
      for (int j = 0; j < 4; ++j) b[j] = Bs[k][tx * 4 + j];
#pragma unroll
      for (int i = 0; i < 4; ++i)
#pragma unroll
        for (int j = 0; j < 4; ++j) acc[i][j] += a[i] * b[j];
    }
    __syncthreads();
  }
#pragma unroll
  for (int i = 0; i < 4; ++i)
#pragma unroll
    for (int j = 0; j < 4; ++j) {
      int row = m0 + ty * 4 + i, col = n0 + tx * 4 + j;
      if (row < M && col < N) C[(size_t)row * ldc + col] = acc[i][j];
    }
}
__device__ __forceinline__ void d_ssd_prep(int vb, int tidp, char* smem, const float* P, const float* conv_w, const float* conv_b, const float* dt_bias, float* XBC, float* DT) {
  size_t idx = (size_t)vb * 256 + tidp;
  if (idx >= (size_t)NT * 776) return;
  int r = (int)(idx / 776), c = (int)(idx % 776);
  if (c < 768) {
    int t, len, base;
    if (r < NL) { t = r % SEQ; len = SEQ; base = r - t; } else { t = (r - NL) % CTX; len = CTX; base = r - t; }
    float s = conv_b[c];
#pragma unroll
    for (int k = 0; k < 5; ++k) {
      int tt = t + k - 2;
      if (tt >= 0 && tt < len) s += conv_w[k * 768 + c] * P[(size_t)(base + tt) * DIN + O_SSD + 256 + c];
    }
    XBC[(size_t)r * 768 + c] = siluf(s);
  } else {
    int j = c - 768;
    DT[(size_t)r * 8 + j] = softplusf(P[(size_t)r * DIN + O_SSD + 1024 + j] + dt_bias[j]);
  }
}
__device__ __forceinline__ void d_ssd_scan(int vb, int tidp, char* smem, const float* XBC, const float* DT, const float* a_log, float* CAT, int dir) {
  int b = vb / 4, h = vb % 4, tid = tidp, p = tid >> 2, q = tid & 3;
  float a_head = -expf(a_log[dir * 4 + h]);
  int grp = h >> 1;
  float st[32];
#pragma unroll
  for (int i = 0; i < 32; ++i) st[i] = 0.f;
  for (int s = 0; s < CTX + SEQ; ++s) {
    int r;
    if (s < CTX) r = NL + b * CTX + (dir ? CTX - 1 - s : s);
    else { int t = s - CTX; r = b * SEQ + (dir ? SEQ - 1 - t : t); }
    float dt = DT[(size_t)r * 8 + dir * 4 + h];
    float g = expf(dt * a_head);
    const float* xr = XBC + (size_t)r * 768;
    float xd = xr[h * 64 + p] * dt;
    const float* Bm = xr + 256 + grp * 128 + q * 32;
    const float* Cm = xr + 512 + grp * 128 + q * 32;
    float y = 0.f;
#pragma unroll
    for (int i = 0; i < 32; ++i) { st[i] = g * st[i] + xd * Bm[i]; y += st[i] * Cm[i]; }
    y += __shfl_xor(y, 1); y += __shfl_xor(y, 2);
    if (q == 0) { float* o = CAT + (size_t)r * DM + h * 64 + p; if (dir) *o += y; else *o = y; }
  }
}
__device__ __forceinline__ void d_ssd_finish(int vb, int tidp, char* smem, const float* P, const float* XBC, const float* d_skip, const float* norm_g, float* CAT, int nrows) {
  int row = (vb * 256 + tidp) / 64, lane = tidp & 63;
  if (row >= nrows) return;
  float v[4]; float ss = 0.f;
#pragma unroll
  for (int i = 0; i < 4; ++i) {
    int c = lane + 64 * i, h = c >> 6;
    float y = CAT[(size_t)row * DM + c] + d_skip[h] * XBC[(size_t)row * 768 + c];
    y *= siluf(P[(size_t)row * DIN + O_SSD + c]);
    v[i] = y; ss += y * y;
  }
  ss = wave_sum(ss);
  float rs = rsqrtf(ss / 256.f + EPS);
#pragma unroll
  for (int i = 0; i < 4; ++i) { int c = lane + 64 * i; CAT[(size_t)row * DM + c] = v[i] * rs * norm_g[c]; }
}
__device__ __forceinline__ void d_gla_prep(int vb, int tidp, char* smem, const float* P, const float* gate_w, const float* gate_b, float* LOGG) {
  size_t idx = (size_t)vb * 256 + tidp;
  if (idx >= (size_t)NT * 256) return;
  int r = (int)(idx >> 8), d = (int)((idx >> 7) & 1), j = (int)(idx & 127);
  float s = gate_b[d * 128 + j];
  for (int k = 0; k < 16; ++k) s += P[(size_t)r * DIN + O_GLA + 768 + d * 16 + k] * gate_w[(d * 16 + k) * 128 + j];
  LOGG[idx] = logsigmoidf(s) * (1.f / 16.f);
}
__device__ __forceinline__ void d_gla_scan(int vb, int tidp, char* smem, const float* P, const float* LOGG, float* CAT, int dir) {
  int wv = vb * 4 + (tidp >> 6); if (wv >= NB * 4) return; int b = wv / 4, h = wv % 4, dv = tidp & 63;
  float S[32];
#pragma unroll
  for (int i = 0; i < 32; ++i) S[i] = 0.f;
  const float qs = 0.17677669529663687f;
  for (int s = 0; s < CTX + SEQ; ++s) {
    int r;
    if (s < CTX) r = NL + b * CTX + (dir ? CTX - 1 - s : s);
    else { int t = s - CTX; r = b * SEQ + (dir ? SEQ - 1 - t : t); }
    const float* pr = P + (size_t)r * DIN + O_GLA;
    const float* lg = LOGG + (size_t)r * 256 + dir * 128 + h * 32;
    float v = pr[256 + h * 64 + dv];
    float o = 0.f;
#pragma unroll
    for (int i = 0; i < 32; ++i) {
      S[i] = expf(lg[i]) * S[i] + pr[128 + h * 32 + i] * v;
      o += pr[h * 32 + i] * qs * S[i];
    }
    float* op = CAT + (size_t)r * DM + 256 + h * 64 + dv;
    if (dir) *op += o; else *op = o;
  }
}
__device__ __forceinline__ void d_gla_finish(int vb, int tidp, char* smem, const float* P, const float* norm_g, float* CAT, int nrows) {
  int w = (vb * 256 + tidp) / 64, lane = tidp & 63;
  if (w >= nrows * 4) return;
  int row = w >> 2, h = w & 3;
  float* op = CAT + (size_t)row * DM + 256 + h * 64 + lane;
  float o = *op;
  float ss = wave_sum(o * o);
  float rs = rsqrtf(ss / 64.f + EPS);
  *op = o * rs * norm_g[lane] * siluf(P[(size_t)row * DIN + O_GLA + 512 + h * 64 + lane]);
}
__device__ __forceinline__ void d_mla_norm(int vb, int tidp, char* smem, const float* P, const float* qg, const float* kvg, float* NQ, float* NKV) {
  int row = (vb * 256 + tidp) / 64, lane = tidp & 63;
  if (row >= NT) return;
  const float* pr = P + (size_t)row * DIN + O_MLA;
  float v[4], ss = 0.f;
#pragma unroll
  for (int i = 0; i < 4; ++i) { v[i] = pr[lane + 64 * i]; ss += v[i] * v[i]; }
  ss = wave_sum(ss);
  float rs = rsqrtf(ss / 256.f + EPS);
#pragma unroll
  for (int i = 0; i < 4; ++i) NQ[(size_t)row * 256 + lane + 64 * i] = v[i] * rs * qg[lane + 64 * i];
  float u[2]; ss = 0.f;
#pragma unroll
  for (int i = 0; i < 2; ++i) { u[i] = pr[256 + lane + 64 * i]; ss += u[i] * u[i]; }
  ss = wave_sum(ss);
  rs = rsqrtf(ss / 128.f + EPS);
#pragma unroll
  for (int i = 0; i < 2; ++i) NKV[(size_t)row * 128 + lane + 64 * i] = u[i] * rs * kvg[lane + 64 * i];
}
__device__ __forceinline__ void d_mla_rope(int vb, int tidp, char* smem, const float* P, float* Q, const float* KVraw, float* K, float* V) {
  size_t idx = (size_t)vb * 256 + tidp;
  if (idx >= (size_t)NT * 4 * 16) return;
  int r = (int)(idx / 64), h = (int)((idx / 16) % 4), i = (int)(idx % 16);
  float cs = 1.f, sn = 0.f;
  if (r < NL) {
    int t = r % SEQ; int rowi = t / GRIDW, coli = t % GRIDW;
    int f = i & 7;
    float inv = powf(10000.f, -(float)(2 * f) / 16.f);
    float ang = (i < 8 ? (float)rowi : (float)coli) * inv;
    cs = cosf(ang); sn = sinf(ang);
  }
  float* q = Q + (size_t)r * 384 + h * 96 + 64;
  float x1 = q[i], x2 = q[i + 16];
  q[i] = x1 * cs - x2 * sn; q[i + 16] = x1 * sn + x2 * cs;
  const float* kr = P + (size_t)r * DIN + O_MLA + 384;
  float k1 = kr[i], k2 = kr[i + 16];
  float* kk = K + (size_t)r * 384 + h * 96;
  kk[64 + i] = k1 * cs - k2 * sn; kk[64 + 16 + i] = k1 * sn + k2 * cs;
  const float* kv = KVraw + (size_t)r * 512 + h * 128;
  for (int j = i; j < 64; j += 16) { kk[j] = kv[j]; V[(size_t)r * 256 + h * 64 + j] = kv[64 + j]; }
}
__device__ __forceinline__ void d_attn(int vb, int tidp, char* smem, const float* Q, const float* K, const float* V, float* CAT, int row0, int nrows) {
  int wv = vb * 4 + (tidp >> 6); int nrb = nrows / 32; if (wv >= nrb * 4) return;
  int lane = tidp & 63, sub = lane & 1;
  int h = wv / nrb; int r = row0 + (wv % nrb) * 32 + (lane >> 1);
  float q[48], o[32];
  const float scale = 0.10206207261596575f;
#pragma unroll
  for (int i = 0; i < 48; ++i) q[i] = Q[(size_t)r * 384 + h * 96 + sub * 48 + i] * scale;
#pragma unroll
  for (int i = 0; i < 32; ++i) o[i] = 0.f;
  float m = -1e30f, l = 0.f;
  int b, nseg; int seg0[2], segn[2];
  if (r < NL) { b = r / SEQ; nseg = 2; seg0[0] = b * SEQ; segn[0] = SEQ; seg0[1] = NL + b * CTX; segn[1] = CTX; }
  else { b = (r - NL) / CTX; nseg = 1; seg0[0] = NL + b * CTX; segn[0] = CTX; seg0[1] = 0; segn[1] = 0; }
  for (int sg = 0; sg < nseg; ++sg)
    for (int j = 0; j < segn[sg]; ++j) {
      const float* kp = K + (size_t)(seg0[sg] + j) * 384 + h * 96 + sub * 48;
      const float* vp = V + (size_t)(seg0[sg] + j) * 256 + h * 64 + sub * 32;
      float s = 0.f;
#pragma unroll
      for (int i = 0; i < 48; ++i) s += q[i] * kp[i];
      s += __shfl_xor(s, 1);
      float mn = fmaxf(m, s);
      float al = expf(m - mn), pp = expf(s - mn);
      l = l * al + pp;
#pragma unroll
      for (int i = 0; i < 32; ++i) o[i] = o[i] * al + pp * vp[i];
      m = mn;
    }
  float il = 1.f / l;
#pragma unroll
  for (int i = 0; i < 32; ++i) CAT[(size_t)r * DM + 512 + h * 64 + sub * 32 + i] = o[i] * il;
}
__device__ __forceinline__ void d_s5_scan(int vb, int tidp, char* smem, const float* P, const float* a_re, const float* a_im, const float* log_dt,
                                                const float* b_re, const float* b_im, const float* c_re, const float* c_im,
                                                float* CAT, int dir) {
  int wv = vb * 4 + (tidp >> 6); if (wv >= NB * 16) return; int b = wv / 16, g = wv % 16, n = tidp & 63;
  float lre = fminf(a_re[(dir * 16 + g) * 64 + n], -1e-4f), lim = a_im[(dir * 16 + g) * 64 + n];
  float step = expf(log_dt[dir * 16 + g]);
  float er = expf(lre * step);
  float ar = er * cosf(lim * step), ai = er * sinf(lim * step);
  float nr = ar - 1.f, ni = ai, den = lre * lre + lim * lim;
  float cr = (nr * lre + ni * lim) / den, ci = (ni * lre - nr * lim) / den;
  float bbr[16], bbi[16], cmr[16], cmi[16];
#pragma unroll
  for (int c = 0; c < 16; ++c) {
    float br = b_re[(g * 64 + n) * 16 + c], bi = b_im[(g * 64 + n) * 16 + c];
    bbr[c] = cr * br - ci * bi; bbi[c] = cr * bi + ci * br;
    cmr[c] = c_re[((dir * 16 + g) * 16 + c) * 64 + n]; cmi[c] = c_im[((dir * 16 + g) * 16 + c) * 64 + n];
  }
  float hr = 0.f, hi = 0.f;
  for (int s = 0; s < CTX + SEQ; ++s) {
    int r;
    if (s < CTX) r = NL + b * CTX + (dir ? CTX - 1 - s : s);
    else { int t = s - CTX; r = b * SEQ + (dir ? SEQ - 1 - t : t); }
    const float* u = P + (size_t)r * DIN + O_S5 + g * 16;
    float bur = 0.f, bui = 0.f;
#pragma unroll
    for (int c = 0; c < 16; ++c) { float uc = u[c]; bur += uc * bbr[c]; bui += uc * bbi[c]; }
    float nhr = ar * hr - ai * hi + bur, nhi = ar * hi + ai * hr + bui;
    hr = nhr; hi = nhi;
    float yv = 0.f;
#pragma unroll
    for (int c = 0; c < 16; ++c) {
      float y = wave_sum(hr * cmr[c] - hi * cmi[c]);
      if (n == c) yv = y;
    }
    if (n < 16) { float* o = CAT + (size_t)r * DM + 768 + g * 16 + n; if (dir) *o += yv; else *o = yv; }
  }
}
__device__ __forceinline__ void d_s5_gelu(int vb, int tidp, char* smem, const float* P, const float* d_skip, float* CAT, int nrows) {
  size_t idx = (size_t)vb * 256 + tidp;
  if (idx >= (size_t)nrows * 256) return;
  int r = (int)(idx >> 8), c = (int)(idx & 255);
  float* o = CAT + (size_t)r * DM + 768 + c;
  *o = geluf(*o + d_skip[c] * P[(size_t)r * DIN + O_S5 + c]);
}
__device__ __forceinline__ void d_s5_glu(int vb, int tidp, char* smem, const float* T, const float* glu_b, float* CAT, int nrows) {
  size_t idx = (size_t)vb * 256 + tidp;
  if (idx >= (size_t)nrows * 256) return;
  int r = (int)(idx >> 8), c = (int)(idx & 255);
  float* o = CAT + (size_t)r * DM + 768 + c;
  *o = *o * sigmoidf_(T[idx] + glu_b[c]);
}
__device__ __forceinline__ void d_resid(int vb, int tidp, char* smem, float* H, const float* X, const float* mod, int imod, int nrows) {
  size_t idx = (size_t)vb * 256 + tidp;
  if (idx >= (size_t)nrows * DM) return;
  int r = (int)(idx >> 10), c = (int)(idx & 1023);
  H[idx] += mod[row_mod(r) * NMOD * DM + imod * DM + c] * X[idx];
}
__device__ __forceinline__ void d_peer_topk(int vb, int tidp, char* smem, const float* QP, const float* sub_keys, int* EIDX, float* GATE) {
  int half = tidp >> 7; smem += half * 4096;
  float* s1 = (float*)smem; float* s2 = s1 + 128; float* v1 = s2 + 128; float* v2 = v1 + 16;
  int* i1 = (int*)(v2 + 16); int* i2 = i1 + 16; float* cand = (float*)(i2 + 16); float* best = cand + 256; int* bidx = (int*)(best + 16);
  int item = vb * 2 + half; int row = item >> 3, h = item & 7, j = tidp & 127;
  const float* q = QP + (size_t)row * DM + h * 128;
  const float* k1 = sub_keys + ((size_t)(0 * 8 + h) * 128 + j) * 64;
  const float* k2 = sub_keys + ((size_t)(1 * 8 + h) * 128 + j) * 64;
  float a = 0.f, b = 0.f;
  for (int d = 0; d < 64; ++d) { a += q[d] * k1[d]; b += q[64 + d] * k2[d]; }
  s1[j] = a; s2[j] = b;
  __syncthreads();
  int ra = 0, rb = 0;
  for (int i = 0; i < 128; ++i) {
    float x = s1[i], y = s2[i];
    ra += (x > a) || (x == a && i < j);
    rb += (y > b) || (y == b && i < j);
  }
  if (ra < 16) { v1[ra] = a; i1[ra] = j; }
  if (rb < 16) { v2[rb] = b; i2[rb] = j; }
  __syncthreads();
  float c0 = v1[j >> 4] + v2[j & 15], c1 = v1[(j + 128) >> 4] + v2[(j + 128) & 15];
  cand[j] = c0; cand[j + 128] = c1;
  __syncthreads();
  int r0 = 0, r1 = 0;
  for (int i = 0; i < 256; ++i) {
    float x = cand[i];
    r0 += (x > c0) || (x == c0 && i < j);
    r1 += (x > c1) || (x == c1 && i < j + 128);
  }
  if (r0 < 16) { best[r0] = c0; bidx[r0] = i1[j >> 4] * 128 + i2[j & 15]; }
  if (r1 < 16) { best[r1] = c1; bidx[r1] = i1[(j + 128) >> 4] * 128 + i2[(j + 128) & 15]; }
  __syncthreads();
  if (j < 16) {
    float mx = best[0];
    float sum = 0.f;
    for (int i = 0; i < 16; ++i) sum += expf(best[i] - mx);
    GATE[(size_t)row * 128 + h * 16 + j] = expf(best[j] - mx) / sum;
    EIDX[(size_t)row * 128 + h * 16 + j] = bidx[j];
  }
  __syncthreads();
}
__device__ __forceinline__ void d_peer_gather(int vb, int tidp, char* smem, const float* F, const int* EIDX, const float* GATE, const float* U, const float* Vt,
                                                     const float* mod, float* H) {
  float* f = (float*)smem; float* wgt = f + 1024; int* eid = (int*)(wgt + 128);
  int row = vb, tid = tidp, lane = tid & 63, w = tid >> 6;
  for (int i = tid; i < 1024; i += 256) f[i] = F[(size_t)row * DM + i];
  if (tid < 128) eid[tid] = EIDX[(size_t)row * 128 + tid];
  __syncthreads();
  for (int kk = 0; kk < 32; ++kk) {
    int k = w * 32 + kk; const float* u = U + (size_t)eid[k] * DM;
    float s = 0.f;
#pragma unroll
    for (int i = 0; i < 16; ++i) s += f[lane + 64 * i] * u[lane + 64 * i];
    s = wave_sum(s);
    if (lane == 0) wgt[k] = GATE[(size_t)row * 128 + k] * geluf(s);
  }
  __syncthreads();
  float acc[4] = {0.f, 0.f, 0.f, 0.f};
  for (int k = 0; k < 128; ++k) {
    const float* v = Vt + (size_t)eid[k] * DM; float wk = wgt[k];
#pragma unroll
    for (int i = 0; i < 4; ++i) acc[i] += wk * v[tid + 256 * i];
  }
  const float* mm = mod + row_mod(row) * NMOD * DM + 5 * DM;
#pragma unroll
  for (int i = 0; i < 4; ++i) { int c = tid + 256 * i; H[(size_t)row * DM + c] += mm[c] * acc[i]; }
  __syncthreads();
}
__device__ __forceinline__ void d_final(int vb, int tidp, char* smem, const float* H, const float* g, float* out) {
  int row = (vb * 256 + tidp) / 64, lane = tidp & 63;
  if (row >= NL) return;
  const float* h = H + (size_t)row * DM;
  float ss = 0.f;
  for (int k = lane; k < DM; k += 64) ss += h[k] * h[k];
  ss = wave_sum(ss);
  float rs = rsqrtf(ss / DM + EPS);
  for (int k = lane; k < DM; k += 64) out[(size_t)row * DM + k] = h[k] * rs * g[k];
}

struct Params {
  const float* in[38];
  float* out;
  char* ws;
};
#ifdef EMU
#define TID() ((int)threadIdx.x)
#else
__device__ __forceinline__ int opaque_tid() { int t = threadIdx.x; asm volatile("" : "+v"(t)); return t; }
#define TID() opaque_tid()
#endif
#define FOR_VB(n) for (int vb = blockIdx.x, nvb_ = (n); vb < nvb_; vb += gridDim.x)
__device__ __forceinline__ int cdivd(size_t a, size_t b) { return (int)((a + b - 1) / b); }

__global__ void __launch_bounds__(256, 2) mega(Params p) {
#ifdef EMU
  char* smem = emu_block_smem();
#else
  __shared__ __attribute__((aligned(16))) char smem[16384];
#endif
  const float* x = p.in[0];       const float* c = p.in[1];
  const float* ctx = p.in[2];     const float* c_ctx = p.in[3];
  const float* ada_w = p.in[4];   const float* ada_b = p.in[5];
  const float* norm_mix_g = p.in[6]; const float* norm_ffn_g = p.in[7];
  const float* w_in = p.in[8];    const float* w_out = p.in[9];
  const float* ssd_conv_w = p.in[10]; const float* ssd_conv_b = p.in[11];
  const float* ssd_a_log = p.in[12];  const float* ssd_dt_bias = p.in[13];
  const float* ssd_d = p.in[14];  const float* ssd_norm_g = p.in[15];
  const float* gla_gate_w = p.in[16]; const float* gla_gate_b = p.in[17];
  const float* gla_norm_g = p.in[18]; const float* mla_q_norm_g = p.in[19];
  const float* mla_w_uq = p.in[20];   const float* mla_kv_norm_g = p.in[21];
  const float* mla_w_ukv = p.in[22];  const float* s5_a_re = p.in[23];
  const float* s5_a_im = p.in[24];    const float* s5_log_dt = p.in[25];
  const float* s5_b_re = p.in[26];    const float* s5_b_im = p.in[27];
  const float* s5_c_re = p.in[28];    const float* s5_c_im = p.in[29];
  const float* s5_d = p.in[30];       const float* s5_glu_w = p.in[31];
  const float* s5_glu_b = p.in[32];   const float* peer_w_q = p.in[33];
  const float* peer_sub_keys = p.in[34]; const float* peer_u = p.in[35];
  const float* peer_v = p.in[36];     const float* final_norm_g = p.in[37];
  float* out = p.out;

  char* wp = p.ws; size_t off = 0;
  auto carve = [&](size_t nfloats) { float* q = (float*)(wp + off); off += ((nfloats * 4 + 255) / 256) * 256; return q; };
  float* MOD = carve(2 * 3 * NMOD * DM);
  float* H = carve((size_t)NT * DM);
  float* P = carve((size_t)NT * DIN);
  float* R2 = carve((size_t)NT * DM);
  float* CAT = carve((size_t)NT * DM);
  float* LOGG = carve((size_t)NT * 256);
  float* Q = carve((size_t)NT * 384);
  float* K = carve((size_t)NT * 384);
  float* V = carve((size_t)NT * 256);
  float* DT = carve((size_t)NT * 8);
  float* SCR = carve((size_t)NT * (256 + 128 + 512));
  float* A = R2; float* XBC = R2;
  float* MIX = P; float* F = P + (size_t)NT * DM; float* QP = P;
  float* NQ = SCR; float* NKV = SCR + (size_t)NT * 256; float* KVraw = NKV + (size_t)NT * 128;
  float* T = SCR; int* EIDX = (int*)SCR; float* GATE = SCR + (size_t)NT * 128;

  FOR_VB(cdivd(2 * 3 * NMOD * DM, 256)) d_mod(vb, TID(), smem, c, c_ctx, ada_w, ada_b, MOD);
  FOR_VB(cdivd((size_t)NT * DM, 256)) d_copy_h(vb, TID(), smem, x, ctx, H);
  GRID_SYNC();
#pragma unroll 1
  for (int l = 0; l < 2; ++l) {
    const float* mod = MOD + (size_t)l * 3 * NMOD * DM;
    const int nact = (l == 0) ? NT : NL;
    FOR_VB(cdivd((size_t)NT * 64, 256)) d_modulate(vb, TID(), smem, H, norm_mix_g + l * DM, mod, 0, 1, A, NT);
    GRID_SYNC();
    FOR_VB(cdivd(DIN, 64) * (NT / 64)) d_gemm(vb, TID(), smem, A, DM, w_in + (size_t)l * DM * DIN, DIN, P, DIN, NT, DIN, DM);
    GRID_SYNC();
    FOR_VB(cdivd((size_t)NT * 776, 256)) d_ssd_prep(vb, TID(), smem, P, ssd_conv_w + l * 5 * 768, ssd_conv_b + l * 768, ssd_dt_bias + l * 8, XBC, DT);
    FOR_VB(cdivd((size_t)NT * 256, 256)) d_gla_prep(vb, TID(), smem, P, gla_gate_w + l * 2 * 16 * 128, gla_gate_b + l * 256, LOGG);
    FOR_VB(cdivd((size_t)NT * 64, 256)) d_mla_norm(vb, TID(), smem, P, mla_q_norm_g + l * 256, mla_kv_norm_g + l * 128, NQ, NKV);
    GRID_SYNC();
    FOR_VB(cdivd(384, 64) * (NT / 64)) d_gemm(vb, TID(), smem, NQ, 256, mla_w_uq + (size_t)l * 256 * 384, 384, Q, 384, NT, 384, 256);
    FOR_VB(cdivd(512, 64) * (NT / 64)) d_gemm(vb, TID(), smem, NKV, 128, mla_w_ukv + (size_t)l * 128 * 512, 512, KVraw, 512, NT, 512, 128);
    GRID_SYNC();
    FOR_VB(cdivd((size_t)NT * 64, 256)) d_mla_rope(vb, TID(), smem, P, Q, KVraw, K, V);
    GRID_SYNC();
    {
      const int n_ssd = NB * 4, n_gla = (NB * 4 + 3) / 4, n_s5 = (NB * 16 + 3) / 4, n_att = (nact / 32 * 4 + 3) / 4;
      FOR_VB(n_ssd + n_gla + n_s5 + n_att) {
        int v = vb;
        if (v < n_ssd) { d_ssd_scan(v, TID(), smem, XBC, DT, ssd_a_log + l * 8, CAT, 0); continue; }
        v -= n_ssd;
        if (v < n_gla) { d_gla_scan(v, TID(), smem, P, LOGG, CAT, 0); continue; }
        v -= n_gla;
        if (v < n_s5) { d_s5_scan(v, TID(), smem, P, s5_a_re + l * 2048, s5_a_im + l * 2048, s5_log_dt + l * 32, s5_b_re + l * 16384, s5_b_im + l * 16384,
                                  s5_c_re + l * 32768, s5_c_im + l * 32768, CAT, 0); continue; }
        v -= n_s5;
        d_attn(v, TID(), smem, Q, K, V, CAT, 0, nact);
      }
      GRID_SYNC();
      FOR_VB(n_ssd + n_gla + n_s5) {
        int v = vb;
        if (v < n_ssd) { d_ssd_scan(v, TID(), smem, XBC, DT, ssd_a_log + l * 8, CAT, 1); continue; }
        v -= n_ssd;
        if (v < n_gla) { d_gla_scan(v, TID(), smem, P, LOGG, CAT, 1); continue; }
        v -= n_gla;
        d_s5_scan(v, TID(), smem, P, s5_a_re + l * 2048, s5_a_im + l * 2048, s5_log_dt + l * 32, s5_b_re + l * 16384, s5_b_im + l * 16384,
                  s5_c_re + l * 32768, s5_c_im + l * 32768, CAT, 1);
      }
      GRID_SYNC();
    }
    FOR_VB(cdivd((size_t)nact * 64, 256)) d_ssd_finish(vb, TID(), smem, P, XBC, ssd_d + l * 4, ssd_norm_g + l * 256, CAT, nact);
    FOR_VB(cdivd((size_t)nact * 4 * 64, 256)) d_gla_finish(vb, TID(), smem, P, gla_norm_g + l * 64, CAT, nact);
    FOR_VB(cdivd((size_t)nact * 256, 256)) d_s5_gelu(vb, TID(), smem, P, s5_d + l * 256, CAT, nact);
    GRID_SYNC();
    FOR_VB(4 * (nact / 64)) d_gemm(vb, TID(), smem, CAT + 768, DM, s5_glu_w + (size_t)l * 65536, 256, T, 256, nact, 256, 256);
    GRID_SYNC();
    FOR_VB(cdivd((size_t)nact * 256, 256)) d_s5_glu(vb, TID(), smem, T, s5_glu_b + l * 256, CAT, nact);
    GRID_SYNC();
    FOR_VB((DM / 64) * (nact / 64)) d_gemm(vb, TID(), smem, CAT, DM, w_out + (size_t)l * DM * DM, DM, MIX, DM, nact, DM, DM);
    GRID_SYNC();
    FOR_VB(cdivd((size_t)nact * DM, 256)) d_resid(vb, TID(), smem, H, MIX, mod, 2, nact);
    GRID_SYNC();
    FOR_VB(cdivd((size_t)nact * 64, 256)) d_modulate(vb, TID(), smem, H, norm_ffn_g + l * DM, mod, 3, 4, F, nact);
    GRID_SYNC();
    FOR_VB((DM / 64) * (nact / 64)) d_gemm(vb, TID(), smem, F, DM, peer_w_q + (size_t)l * DM * DM, DM, QP, DM, nact, DM, DM);
    GRID_SYNC();
    FOR_VB(nact * 8 / 2) d_peer_topk(vb, TID(), smem, QP, peer_sub_keys + (size_t)l * 2 * 8 * 128 * 64, EIDX, GATE);
    GRID_SYNC();
    FOR_VB(nact) d_peer_gather(vb, TID(), smem, F, EIDX, GATE, peer_u + (size_t)l * 16384 * DM, peer_v + (size_t)l * 16384 * DM, mod, H);
    GRID_SYNC();
  }
  FOR_VB(cdivd((size_t)NL * 64, 256)) d_final(vb, TID(), smem, H, final_norm_g, out);
}
}

extern "C" void kernel_launch(void* const* d_in, const int* in_sizes, int n_in, void* d_out, int out_size, void* d_ws,
                              size_t ws_size, hipStream_t stream) {
  Params p{};
  for (int i = 0; i < 38; ++i) p.in[i] = (const float*)d_in[i];
  p.out = (float*)d_out; p.ws = (char*)d_ws;
  if ((size_t)NT * 7760 * 4 + (1 << 20) > ws_size) return;
  static int grid_blocks = 0;
  if (!grid_blocks) {
    int dev = 0, cus = 0, per_cu = 0;
    hipGetDevice(&dev);
    hipDeviceGetAttribute(&cus, hipDeviceAttributeMultiprocessorCount, dev);
#ifdef EMU
    per_cu = 2;
#else
    hipOccupancyMaxActiveBlocksPerMultiprocessor(&per_cu, (const void*)mega, 256, 0);
#endif
    if (per_cu > 2) per_cu = 2;
    grid_blocks = cus * per_cu;
  }
  if (grid_blocks <= 0) return;
#ifdef EMU
  emu_launch(dim3(grid_blocks), dim3(256), true, [=]() { mega(p); });
#else
  void* args[] = {&p};
  hipError_t e = hipLaunchCooperativeKernel((void*)mega, dim3(grid_blocks), dim3(256), args, 0, stream);
  if (e != hipSuccess) fprintf(stderr, "cooperative launch failed: %s (grid %d)\n", hipGetErrorString(e), grid_blocks);
#endif
}
```

```cpp
#ifndef EMU
#include <hip/hip_runtime.h>
#include <hip/hip_cooperative_groups.h>
#include <cstdio>
#endif
#include <stdint.h>
#include <stddef.h>

#ifndef SEQ_
#define SEQ_ 8192
#endif
#ifndef CTX_
#define CTX_ 256
#endif

#ifdef EMU
#define GRID_SYNC() emu_grid_sync()
#else
#define XB_TMO      128
#define XB_XCNT(j)  (256  + 64 * (j))
#define XB_XSUB(j)  (1280 + 64 * (j))
#define XB_XGEN(j)  (2304 + 64 * (j))
#define XB_TOP      3328
#define XB_TOPGEN   3392
#define XCD_BAR_WORDS 3456
#define XB_SPIN_CAP (1u << 24)
__device__ __forceinline__ unsigned xb_ld(unsigned* p)              { return __hip_atomic_load(p, __ATOMIC_RELAXED, __HIP_MEMORY_SCOPE_AGENT); }
__device__ __forceinline__ unsigned xb_add(unsigned* p, unsigned v) { return __hip_atomic_fetch_add(p, v, __ATOMIC_RELAXED, __HIP_MEMORY_SCOPE_AGENT); }
#define XB_SPIN(cond, bar) do { unsigned _sp = 0; while (cond) { __builtin_amdgcn_s_sleep(1); \
    if ((++_sp & 255u) == 0u) { if (xb_ld(&(bar)[XB_TMO])) break; if (_sp > XB_SPIN_CAP) { atomicAdd(&(bar)[XB_TMO], 1u); break; } } } } while (0)
struct XBar { unsigned* bar; unsigned x; volatile unsigned* st; };
__device__ __forceinline__ XBar xbar_init(unsigned* bar, volatile unsigned* st) {
  XBar b; b.bar = bar; b.x = (unsigned)__builtin_amdgcn_s_getreg((3 << 11) | 20) & 0xFu; b.st = st;
  if (threadIdx.x == 0) {
    (void)xb_add(&bar[XB_XCNT(b.x)], 1u);
    const unsigned G = gridDim.x;
    unsigned sum, cnt, mine, sp = 0u;
    for (;;) {
      sum = 0u; cnt = 0u; mine = 0u;
#pragma unroll
      for (unsigned j = 0; j < 16; ++j) { const unsigned c = xb_ld(&bar[XB_XCNT(j)]); sum += c; cnt += (c > 0u) ? 1u : 0u; mine = (j == b.x) ? c : mine; }
      if (sum == G) break;
      __builtin_amdgcn_s_sleep(1);
      if ((++sp & 255u) == 0u) { if (xb_ld(&bar[XB_TMO])) break; if (sp > XB_SPIN_CAP) { atomicAdd(&bar[XB_TMO], 1u); break; } }
    }
    st[0] = mine > 0u ? mine : 1u; st[1] = cnt > 0u ? cnt : 1u;
  }
  __syncthreads();
  return b;
}
__device__ __forceinline__ void xbar_sync(const XBar& b) {
  asm volatile("s_waitcnt vmcnt(0)" ::: "memory");
  __syncthreads();
  if (threadIdx.x == 0) {
    unsigned* bar = b.bar;
    __builtin_amdgcn_s_waitcnt(0);
    const unsigned nloc = b.st[0], nx = b.st[1];
    const unsigned old = xb_add(&bar[XB_XSUB(b.x)], 1u);
    const unsigned gen = old / nloc;
    if (old + 1u == (gen + 1u) * nloc) {
      __builtin_amdgcn_fence(__ATOMIC_RELEASE, "agent");
      asm volatile("s_waitcnt vmcnt(0)" ::: "memory");
      const unsigned og = xb_add(&bar[XB_TOP], 1u);
      const unsigned tg = og / nx;
      if (og + 1u == (tg + 1u) * nx) xb_add(&bar[XB_TOPGEN], 1u);
      else XB_SPIN(xb_ld(&bar[XB_TOPGEN]) == tg, bar);
      __builtin_amdgcn_fence(__ATOMIC_ACQUIRE, "agent");
      xb_add(&bar[XB_XGEN(b.x)], 1u);
      asm volatile("s_waitcnt vmcnt(0)" ::: "memory");
    } else {
      XB_SPIN(xb_ld(&bar[XB_XGEN(b.x)]) == gen, bar);
      __builtin_amdgcn_fence(__ATOMIC_ACQUIRE, "agent");
      asm volatile("s_waitcnt vmcnt(0)" ::: "memory");
    }
  }
  __syncthreads();
}
#define GRID_SYNC() xbar_sync(xbar)
#endif

namespace {
constexpr int DM = 1024, NB = 2, SEQ = SEQ_, CTX = CTX_, GRIDW = 64;
constexpr int NL = NB * SEQ, NC = NB * CTX, NT = NL + NC;
constexpr int DIN = 2504, NMOD = 6;
constexpr int O_SSD = 0, O_GLA = 1032, O_MLA = 1832, O_S5 = 2248;
constexpr float EPS = 1e-6f;

__device__ __forceinline__ float siluf(float x) { return x / (1.f + expf(-x)); }
__device__ __forceinline__ float sigmoidf_(float x) { return 1.f / (1.f + expf(-x)); }
__device__ __forceinline__ float softplusf(float x) { return x > 20.f ? x : log1pf(expf(x)); }
__device__ __forceinline__ float logsigmoidf(float x) { return -softplusf(-x); }
__device__ __forceinline__ float geluf(float x) { return 0.5f * x * (1.f + erff(x * 0.70710678118654752f)); }
__device__ __forceinline__ float wave_sum(float v) {
#pragma unroll
  for (int m = 32; m >= 1; m >>= 1) v += __shfl_xor(v, m);
  return v;
}
__device__ __forceinline__ int row_mod(int r) { return r < NL ? r / SEQ : 2; }


typedef short s8v __attribute__((ext_vector_type(8)));
typedef float f16v __attribute__((ext_vector_type(16)));
typedef float f4v __attribute__((ext_vector_type(4)));
typedef unsigned short bf16_t;
#ifdef EMU
static inline unsigned __float_as_uint(float f) { unsigned u; memcpy(&u, &f, 4); return u; }
static inline float __uint_as_float(unsigned u) { float f; memcpy(&f, &u, 4); return f; }
#endif
__device__ __forceinline__ bf16_t f2bf(float f) { unsigned u = __float_as_uint(f); u += 0x7fffu + ((u >> 16) & 1u); return (bf16_t)(u >> 16); }
__device__ __forceinline__ unsigned pack_bf2(float a, float b) { return (unsigned)f2bf(a) | ((unsigned)f2bf(b) << 16); }
__device__ __forceinline__ float bf2f(bf16_t b) { return __uint_as_float((unsigned)b << 16); }
__device__ __forceinline__ float bflo(unsigned u) { return __uint_as_float(u << 16); }
__device__ __forceinline__ float bfhi(unsigned u) { return __uint_as_float(u & 0xffff0000u); }

constexpr int PLD = 2560;
struct PRow { const bf16_t* p; __device__ __forceinline__ float operator[](int i) const { return bf2f(p[i]); } };
__device__ __forceinline__ void d_transpose_w(int vb, int tid, char* smem, const float* W, bf16_t* Wt, int K, int N, int Npad) {
  float (*tile)[65] = (float (*)[65])smem;
  int nkt = K / 64; int kt = vb % nkt, nt = vb / nkt;
#pragma unroll 4
  for (int i = 0; i < 16; ++i) {
    int kk = i * 4 + (tid >> 6), nn = tid & 63; int n = nt * 64 + nn;
    tile[kk][nn] = (n < N) ? W[(size_t)(kt * 64 + kk) * N + n] : 0.f;
  }
  __syncthreads();
#pragma unroll 4
  for (int i = 0; i < 16; ++i) {
    int nn = i * 4 + (tid >> 6), kk = tid & 63;
    Wt[(size_t)(nt * 64 + nn) * K + kt * 64 + kk] = f2bf(tile[kk][nn]);
  }
  __syncthreads();
}
__device__ __forceinline__ void d_shiftvec(int vb, int tid, const float* W, int N, const float* mod, int ishift, float* T, int ldt) {
  int idx = vb * 256 + tid; if (idx >= 3 * N) return;
  int mb = idx / N, n = idx % N;
  const float* sh = mod + mb * NMOD * DM + ishift * DM;
  float s = 0.f;
  for (int k = 0; k < DM; ++k) s += sh[k] * W[(size_t)k * N + n];
  T[mb * ldt + n] = s;
}
__device__ __forceinline__ void d_gainvec(int vb, int tid, const float* g, const float* mod, int iscale, float* G) {
  int idx = vb * 256 + tid; if (idx >= 3 * DM) return;
  int mb = idx / DM, k = idx % DM;
  G[idx] = g[k] * (1.f + mod[mb * NMOD * DM + iscale * DM + k]);
}

template <bool AF32, bool SUMSQ, class Epi>
__device__ __forceinline__ void gemm128(int tid, char* smem, const void* Aptr, int lda, const float* gain, const bf16_t* Wt, int ldw, int K,
                                        int m0, int n0, Epi epi) {
  const int lane = tid & 63, w = tid >> 6, wm = w >> 1, wn = w & 1;
  f16v acc[2][2];
#pragma unroll
  for (int i = 0; i < 2; ++i)
#pragma unroll
    for (int j = 0; j < 2; ++j)
#pragma unroll
      for (int r = 0; r < 16; ++r) acc[i][j][r] = 0.f;
  float ss[8];
#pragma unroll
  for (int i = 0; i < 8; ++i) ss[i] = 0.f;
  float4 raf[8]; uint4 rab[4]; uint4 rb[4];
  const int nk = K / 64;
  auto load_tile = [&](int kt) {
    const int k0 = kt * 64;
    if (AF32) {
      const float* A = (const float*)Aptr;
      const int c4 = tid & 15;
#pragma unroll
      for (int i = 0; i < 8; ++i) {
        int row = (tid >> 4) + 16 * i;
        raf[i] = *(const float4*)(A + (size_t)(m0 + row) * lda + k0 + c4 * 4);
      }
    } else {
      const bf16_t* A = (const bf16_t*)Aptr;
      const int c = tid & 7;
#pragma unroll
      for (int i = 0; i < 4; ++i) {
        int row = (tid >> 3) + 32 * i;
        rab[i] = *(const uint4*)(A + (size_t)(m0 + row) * lda + k0 + c * 8);
      }
    }
    {
      const int c = tid & 7;
#pragma unroll
      for (int i = 0; i < 4; ++i) {
        int row = (tid >> 3) + 32 * i;
        rb[i] = *(const uint4*)(Wt + (size_t)(n0 + row) * ldw + k0 + c * 8);
      }
    }
  };
  auto store_tile = [&](int kt, int buf) {
    char* bA = smem + buf * 16384; char* bB = smem + 32768 + buf * 16384;
    if (AF32) {
      const int c4 = tid & 15;
      float4 g = make_float4(1.f, 1.f, 1.f, 1.f);
      if (gain) g = *(const float4*)(gain + kt * 64 + c4 * 4);
#pragma unroll
      for (int i = 0; i < 8; ++i) {
        int row = (tid >> 4) + 16 * i;
        float4 v = raf[i];
        if (SUMSQ) ss[i] += v.x * v.x + v.y * v.y + v.z * v.z + v.w * v.w;
        uint2 pk = make_uint2(pack_bf2(v.x * g.x, v.y * g.y), pack_bf2(v.z * g.z, v.w * g.w));
        *(uint2*)(bA + row * 128 + ((((c4 >> 1) ^ ((row >> 1) & 7))) << 4) + (c4 & 1) * 8) = pk;
      }
    } else {
      const int c = tid & 7;
#pragma unroll
      for (int i = 0; i < 4; ++i) {
        int row = (tid >> 3) + 32 * i;
        *(uint4*)(bA + row * 128 + ((c ^ ((row >> 1) & 7)) << 4)) = rab[i];
      }
    }
    {
      const int c = tid & 7;
#pragma unroll
      for (int i = 0; i < 4; ++i) {
        int row = (tid >> 3) + 32 * i;
        *(uint4*)(bB + row * 128 + ((c ^ ((row >> 1) & 7)) << 4)) = rb[i];
      }
    }
  };
  load_tile(0);
  store_tile(0, 0);
  __syncthreads();
  for (int kt = 0; kt < nk; ++kt) {
    const int buf = kt & 1;
    if (kt + 1 < nk) load_tile(kt + 1);
    const char* bA = smem + buf * 16384; const char* bB = smem + 32768 + buf * 16384;
#pragma unroll
    for (int ks = 0; ks < 4; ++ks) {
      s8v af[2], bfr[2];
      const int c = ks * 2 + (lane >> 5);
#pragma unroll
      for (int t = 0; t < 2; ++t) {
        int ra = wm * 64 + t * 32 + (lane & 31);
        af[t] = *(const s8v*)(bA + ra * 128 + ((c ^ ((ra >> 1) & 7)) << 4));
        int rbb = wn * 64 + t * 32 + (lane & 31);
        bfr[t] = *(const s8v*)(bB + rbb * 128 + ((c ^ ((rbb >> 1) & 7)) << 4));
      }
#pragma unroll
      for (int i = 0; i < 2; ++i)
#pragma unroll
        for (int j = 0; j < 2; ++j) acc[i][j] = __builtin_amdgcn_mfma_f32_32x32x16_bf16(af[i], bfr[j], acc[i][j], 0, 0, 0);
    }
    if (kt + 1 < nk) store_tile(kt + 1, buf ^ 1);
    __syncthreads();
  }
  float* rs_lds = (float*)smem;
  if (SUMSQ) {
#pragma unroll
    for (int i = 0; i < 8; ++i) {
      float s = ss[i];
      s += __shfl_xor(s, 1); s += __shfl_xor(s, 2); s += __shfl_xor(s, 4); s += __shfl_xor(s, 8);
      if ((tid & 15) == 0) rs_lds[(tid >> 4) + 16 * i] = rsqrtf(s / (float)K + EPS);
    }
    __syncthreads();
  }
#pragma unroll
  for (int i = 0; i < 2; ++i)
#pragma unroll
    for (int j = 0; j < 2; ++j)
#pragma unroll
      for (int r = 0; r < 16; ++r) {
        int rl = wm * 64 + i * 32 + (r & 3) + 8 * (r >> 2) + 4 * (lane >> 5);
        int col = n0 + wn * 64 + j * 32 + (lane & 31);
        epi(m0 + rl, col, acc[i][j][r], SUMSQ ? rs_lds[rl] : 1.f);
      }
  __syncthreads();
}
struct EpiStoreF32 {
  float* C; int ldc; int N; const float* bias; int ldb;
  __device__ __forceinline__ void operator()(int row, int col, float v, float rs) const {
    if (col < N) C[(size_t)row * ldc + col] = rs * v + (bias ? bias[row_mod(row) * ldb + col] : 0.f);
  }
};
struct EpiStoreBf16 {
  bf16_t* C; int ldc; const float* bias; int ldb;
  __device__ __forceinline__ void operator()(int row, int col, float v, float rs) const {
    C[(size_t)row * ldc + col] = f2bf(rs * v + (bias ? bias[row_mod(row) * ldb + col] : 0.f));
  }
};
struct EpiResid {
  float* H; const float* mod; int imod;
  __device__ __forceinline__ void operator()(int row, int col, float v, float) const {
    H[(size_t)row * DM + col] += mod[row_mod(row) * NMOD * DM + imod * DM + col] * v;
  }
};

__device__ __forceinline__ void d_mod(int vb, int tidp, char* smem, const float* c, const float* c_ctx, const float* ada_w, const float* ada_b, float* mod) {
  int idx = vb * 256 + tidp;
  if (idx >= 2 * 3 * NMOD * DM) return;
  int j = idx % (NMOD * DM); int m = (idx / (NMOD * DM)) % 3; int l = idx / (3 * NMOD * DM);
  const float* cv = m < 2 ? c + m * DM : c_ctx;
  const float* w = ada_w + (size_t)l * DM * NMOD * DM;
  float s = 0.f;
  for (int k = 0; k < DM; ++k) s += siluf(cv[k]) * w[(size_t)k * NMOD * DM + j];
  mod[idx] = s + ada_b[l * NMOD * DM + j];
}
__device__ __forceinline__ void d_copy_h(int vb, int tidp, char* smem, const float* x, const float* ctx, float* H) {
  size_t i = (size_t)vb * 256 + tidp;
  if (i >= (size_t)NT * DM) return;
  H[i] = i < (size_t)NL * DM ? x[i] : ctx[i - (size_t)NL * DM];
}
__device__ __forceinline__ void d_modulate(int vb, int tidp, char* smem, const float* H, const float* g, const float* mod, int ishift, int iscale, float* A, int nrows) {
  int wave = (vb * 256 + tidp) / 64, lane = tidp & 63;
  if (wave >= nrows) return;
  const float* h = H + (size_t)wave * DM;
  float ss = 0.f;
  for (int k = lane; k < DM; k += 64) ss += h[k] * h[k];
  ss = wave_sum(ss);
  float rs = rsqrtf(ss / DM + EPS);
  const float* mm = mod + row_mod(wave) * NMOD * DM;
  for (int k = lane; k < DM; k += 64)
    A[(size_t)wave * DM + k] = h[k] * rs * g[k] * (1.f + mm[iscale * DM + k]) + mm[ishift * DM + k];
}
__device__ __forceinline__ void d_gemm(int vb, int tidp, char* smem, const float* A, int lda, const float* W, int ldw, float* C, int ldc, int M, int N, int K) {
  float (*As)[68] = (float (*)[68])smem;
  float (*Bs)[68] = (float (*)[68])(smem + 16 * 68 * 4);
  int tid = tidp, tx = tid & 15, ty = tid >> 4;
  int nbx = (N + 63) / 64; int m0 = (vb / nbx) * 64, n0 = (vb % nbx) * 64;
  float acc[4][4];
#pragma unroll
  for (int i = 0; i < 4; ++i)
#pragma unroll
    for (int j = 0; j < 4; ++j) acc[i][j] = 0.f;
  for (int k0 = 0; k0 < K; k0 += 16) {
    {
      int r = tid >> 2, kk = (tid & 3) * 4;
#pragma unroll
      for (int j = 0; j < 4; ++j) {
        int row = m0 + r;
        As[kk + j][r] = (row < M) ? A[(size_t)row * lda + k0 + kk + j] : 0.f;
      }
      int kr = tid >> 4, nn = (tid & 15) * 4;
#pragma unroll
      for (int j = 0; j < 4; ++j) {
        int col = n0 + nn + j;
        Bs[kr][nn + j] = (col < N) ? W[(size_t)(k0 + kr) * ldw + col] : 0.f;
      }
    }
    __syncthreads();
#pragma unroll
    for (int k = 0; k < 16; ++k) {
      float a[4], b[4];
#pragma unroll
      for (int i = 0; i < 4; ++i) a[i] = As[k][ty * 4 + i];
#pragma unroll
      for (int j = 0; j < 4; ++j) b[j] = Bs[k][tx * 4 + j];
#pragma unroll
      for (int i = 0; i < 4; ++i)
#pragma unroll
        for (int j = 0; j < 4; ++j) acc[i][j] += a[i] * b[j];
    }
    __syncthreads();
  }
#pragma unroll
  for (int i = 0; i < 4; ++i)
#pragma unroll
    for (int j = 0; j < 4; ++j) {
      int row = m0 + ty * 4 + i, col = n0 + tx * 4 + j;
      if (row < M && col < N) C[(size_t)row * ldc + col] = acc[i][j];
    }
}
__device__ __forceinline__ void d_ssd_prep(int vb, int tidp, char* smem, const bf16_t* P, const float* conv_w, const float* conv_b, const float* dt_bias, float* XBC, float* DT) {
  size_t idx = (size_t)vb * 256 + tidp;
  if (idx >= (size_t)NT * 776) return;
  int r = (int)(idx / 776), c = (int)(idx % 776);
  if (c < 768) {
    int t, len, base;
    if (r < NL) { t = r % SEQ; len = SEQ; base = r - t; } else { t = (r - NL) % CTX; len = CTX; base = r - t; }
    float s = conv_b[c];
#pragma unroll
    for (int k = 0; k < 5; ++k) {
      int tt = t + k - 2;
      if (tt >= 0 && tt < len) s += conv_w[k * 768 + c] * bf2f(P[(size_t)(base + tt) * PLD + O_SSD + 256 + c]);
    }
    XBC[(size_t)r * 768 + c] = siluf(s);
  } else {
    int j = c - 768;
    DT[(size_t)r * 8 + j] = softplusf(bf2f(P[(size_t)r * PLD + O_SSD + 1024 + j]) + dt_bias[j]);
  }
}
__device__ __forceinline__ void d_ssd_scan(int vb, int tidp, char* smem, const float* XBC, const float* DT, const float* a_log, float* CAT, int dir) {
  int b = vb / 4, h = vb % 4, tid = tidp, p = tid >> 2, q = tid & 3;
  float a_head = -expf(a_log[dir * 4 + h]);
  int grp = h >> 1;
  float st[32];
#pragma unroll
  for (int i = 0; i < 32; ++i) st[i] = 0.f;
  for (int s = 0; s < CTX + SEQ; ++s) {
    int r;
    if (s < CTX) r = NL + b * CTX + (dir ? CTX - 1 - s : s);
    else { int t = s - CTX; r = b * SEQ + (dir ? SEQ - 1 - t : t); }
    float dt = DT[(size_t)r * 8 + dir * 4 + h];
    float g = expf(dt * a_head);
    const float* xr = XBC + (size_t)r * 768;
    float xd = xr[h * 64 + p] * dt;
    const float* Bm = xr + 256 + grp * 128 + q * 32;
    const float* Cm = xr + 512 + grp * 128 + q * 32;
    float y = 0.f;
#pragma unroll
    for (int i = 0; i < 32; ++i) { st[i] = g * st[i] + xd * Bm[i]; y += st[i] * Cm[i]; }
    y += __shfl_xor(y, 1); y += __shfl_xor(y, 2);
    if (q == 0) { float* o = CAT + (size_t)r * DM + h * 64 + p; if (dir) *o += y; else *o = y; }
  }
}
__device__ __forceinline__ void d_ssd_finish(int vb, int tidp, char* smem, const bf16_t* P, const float* XBC, const float* d_skip, const float* norm_g, float* CAT, int nrows) {
  int row = (vb * 256 + tidp) / 64, lane = tidp & 63;
  if (row >= nrows) return;
  float v[4]; float ss = 0.f;
#pragma unroll
  for (int i = 0; i < 4; ++i) {
    int c = lane + 64 * i, h = c >> 6;
    float y = CAT[(size_t)row * DM + c] + d_skip[h] * XBC[(size_t)row * 768 + c];
    y *= siluf(bf2f(P[(size_t)row * PLD + O_SSD + c]));
    v[i] = y; ss += y * y;
  }
  ss = wave_sum(ss);
  float rs = rsqrtf(ss / 256.f + EPS);
#pragma unroll
  for (int i = 0; i < 4; ++i) { int c = lane + 64 * i; CAT[(size_t)row * DM + c] = v[i] * rs * norm_g[c]; }
}
__device__ __forceinline__ void d_gla_prep(int vb, int tidp, char* smem, const bf16_t* P, const float* gate_w, const float* gate_b, float* LOGG) {
  size_t idx = (size_t)vb * 256 + tidp;
  if (idx >= (size_t)NT * 256) return;
  int r = (int)(idx >> 8), d = (int)((idx >> 7) & 1), j = (int)(idx & 127);
  float s = gate_b[d * 128 + j];
  for (int k = 0; k < 16; ++k) s += bf2f(P[(size_t)r * PLD + O_GLA + 768 + d * 16 + k]) * gate_w[(d * 16 + k) * 128 + j];
  LOGG[idx] = logsigmoidf(s) * (1.f / 16.f);
}
__device__ __forceinline__ void d_gla_scan(int vb, int tidp, char* smem, const bf16_t* P, const float* LOGG, float* CAT, int dir) {
  int wv = vb * 4 + (tidp >> 6); if (wv >= NB * 4) return; int b = wv / 4, h = wv % 4, dv = tidp & 63;
  float S[32];
#pragma unroll
  for (int i = 0; i < 32; ++i) S[i] = 0.f;
  const float qs = 0.17677669529663687f;
  for (int s = 0; s < CTX + SEQ; ++s) {
    int r;
    if (s < CTX) r = NL + b * CTX + (dir ? CTX - 1 - s : s);
    else { int t = s - CTX; r = b * SEQ + (dir ? SEQ - 1 - t : t); }
    PRow pr{P + (size_t)r * PLD + O_GLA};
    const float* lg = LOGG + (size_t)r * 256 + dir * 128 + h * 32;
    float v = pr[256 + h * 64 + dv];
    float o = 0.f;
#pragma unroll
    for (int i = 0; i < 32; ++i) {
      S[i] = expf(lg[i]) * S[i] + pr[128 + h * 32 + i] * v;
      o += pr[h * 32 + i] * qs * S[i];
    }
    float* op = CAT + (size_t)r * DM + 256 + h * 64 + dv;
    if (dir) *op += o; else *op = o;
  }
}
__device__ __forceinline__ void d_gla_finish(int vb, int tidp, char* smem, const bf16_t* P, const float* norm_g, float* CAT, int nrows) {
  int w = (vb * 256 + tidp) / 64, lane = tidp & 63;
  if (w >= nrows * 4) return;
  int row = w >> 2, h = w & 3;
  float* op = CAT + (size_t)row * DM + 256 + h * 64 + lane;
  float o = *op;
  float ss = wave_sum(o * o);
  float rs = rsqrtf(ss / 64.f + EPS);
  *op = o * rs * norm_g[lane] * siluf(bf2f(P[(size_t)row * PLD + O_GLA + 512 + h * 64 + lane]));
}
constexpr int NCH128 = (CTX + SEQ) / 128, NCC128 = CTX / 128;
__device__ __forceinline__ int chunk128_row0(int b, int c) { return c < NCC128 ? NL + b * CTX + c * 128 : b * SEQ + (c - NCC128) * 128; }
__device__ __forceinline__ int chain128(int dir, int k) { return dir == 0 ? k : (k < NCC128 ? NCC128 - 1 - k : NCH128 - 1 - (k - NCC128)); }
constexpr int SSD_LDT = 136;
__device__ __forceinline__ void ssd_A(int item, int tid, char* smem, const bf16_t* P, const float* conv_w, const float* conv_b, const float* a_log,
                                      const float* dt_bias, bf16_t* XBC, bf16_t* XT, float* DA, float* ST) {
  const int h = item & 3, c = (item >> 2) % NCH128, b = (item >> 2) / NCH128, g = h >> 1;
  const int w = tid >> 6, lane = tid & 63;
  const int row0 = chunk128_row0(b, c);
  const int t0 = (c < NCC128) ? c * 128 : (c - NCC128) * 128, len = (c < NCC128) ? CTX : SEQ;
  bf16_t* xT = (bf16_t*)smem;
  bf16_t* BT = (bf16_t*)(smem + 64 * SSD_LDT * 2);
  float* acs = (float*)(smem + 192 * SSD_LDT * 2);
  float* wls = acs + 256;
  const int nsets = (h & 1) ? 3 : 5;
  for (int s = 0; s < nsets; ++s) {
    const int col = (s == 0) ? h * 64 + lane : (s < 3 ? 256 + g * 128 + (s - 1) * 64 + lane : 512 + g * 128 + (s - 3) * 64 + lane);
    float cw[5];
#pragma unroll
    for (int k = 0; k < 5; ++k) cw[k] = conv_w[k * 768 + col];
    const float cb = conv_b[col];
    float win[5];
#pragma unroll
    for (int k = 0; k < 4; ++k) { const int tt = t0 + w * 32 - 2 + k; win[k + 1] = (tt >= 0 && tt < len) ? bf2f(P[(size_t)(row0 + w * 32 - 2 + k) * PLD + O_SSD + 256 + col]) : 0.f; }
    float prev = 0.f;
    for (int j = 0; j < 32; ++j) {
      const int tl = w * 32 + j;
#pragma unroll
      for (int k = 0; k < 4; ++k) win[k] = win[k + 1];
      { const int tt = t0 + tl + 2; win[4] = (tt < len) ? bf2f(P[(size_t)(row0 + tl + 2) * PLD + O_SSD + 256 + col]) : 0.f; }
      float y = cb;
#pragma unroll
      for (int k = 0; k < 5; ++k) y += cw[k] * win[k];
      y = siluf(y);
      XBC[(size_t)(row0 + tl) * 768 + col] = f2bf(y);
      if (s < 3) {
        if (j & 1) {
          bf16_t* dst = (s == 0) ? xT + lane * SSD_LDT : BT + ((s - 1) * 64 + lane) * SSD_LDT;
          *(unsigned*)(dst + tl - 1) = pack_bf2(prev, y);
        }
        prev = y;
      }
    }
  }
  if (w < 2) {
    const int dir = w;
    const float bias = dt_bias[dir * 4 + h], ah = -expf(a_log[dir * 4 + h]);
    const float d0 = softplusf(bf2f(P[(size_t)(row0 + 2 * lane) * PLD + O_SSD + 1024 + dir * 4 + h]) + bias);
    const float d1 = softplusf(bf2f(P[(size_t)(row0 + 2 * lane + 1) * PLD + O_SSD + 1024 + dir * 4 + h]) + bias);
    const float s0 = d0 * ah, s1 = d1 * ah;
    float pre = s0 + s1;
#pragma unroll
    for (int o = 1; o < 64; o <<= 1) { const float v = __shfl_up(pre, o); if (lane >= o) pre += v; }
    const float tot = __shfl(pre, 63);
    float a0, a1;
    if (dir == 0) { a0 = pre - s1; a1 = pre; } else { const float suf = tot - pre + s0 + s1; a0 = suf; a1 = suf - s0; }
    float* da = DA + (size_t)((((b * NCH128 + c) * 2 + dir) * 4 + h) * 2) * 128;
    da[2 * lane] = a0; da[2 * lane + 1] = a1; da[128 + 2 * lane] = d0; da[128 + 2 * lane + 1] = d1;
    wls[dir * 128 + 2 * lane] = expf(tot - a0) * d0; wls[dir * 128 + 2 * lane + 1] = expf(tot - a1) * d1;
  }
  __syncthreads();
  {
    bf16_t* xt = XT + (size_t)((b * NCH128 + c) * 4 + h) * 64 * 128;
#pragma unroll
    for (int i = 0; i < 4; ++i) {
      const int id = tid + 256 * i, p = id >> 4, ch = id & 15;
      *(uint4*)(xt + p * 128 + ch * 8) = *(const uint4*)(xT + p * SSD_LDT + ch * 8);
    }
  }
  {
    const int dir = w >> 1, pt = w & 1;
    f16v acc[4];
#pragma unroll
    for (int i = 0; i < 4; ++i)
#pragma unroll
      for (int r = 0; r < 16; ++r) acc[i][r] = 0.f;
#pragma unroll 2
    for (int ks = 0; ks < 8; ++ks) {
      const int j0 = ks * 16 + 8 * (lane >> 5);
      const uint4 xa = *(const uint4*)(xT + (pt * 32 + (lane & 31)) * SSD_LDT + j0);
      const float4 w0 = *(const float4*)(wls + dir * 128 + j0), w1 = *(const float4*)(wls + dir * 128 + j0 + 4);
      uint4 xs;
      xs.x = pack_bf2(bflo(xa.x) * w0.x, bfhi(xa.x) * w0.y); xs.y = pack_bf2(bflo(xa.y) * w0.z, bfhi(xa.y) * w0.w);
      xs.z = pack_bf2(bflo(xa.z) * w1.x, bfhi(xa.z) * w1.y); xs.w = pack_bf2(bflo(xa.w) * w1.z, bfhi(xa.w) * w1.w);
      s8v af; __builtin_memcpy(&af, &xs, 16);
#pragma unroll
      for (int nt = 0; nt < 4; ++nt) {
        const s8v bfr = *(const s8v*)(BT + (nt * 32 + (lane & 31)) * SSD_LDT + j0);
        acc[nt] = __builtin_amdgcn_mfma_f32_32x32x16_bf16(af, bfr, acc[nt], 0, 0, 0);
      }
    }
    float* st = ST + ((size_t)((b * 2 + dir) * 4 + h) * NCH128 + c) * 8192;
#pragma unroll
    for (int nt = 0; nt < 4; ++nt)
#pragma unroll
      for (int r = 0; r < 16; ++r) {
        const int p = pt * 32 + (r & 3) + 8 * (r >> 2) + 4 * (lane >> 5);
        st[p * 128 + nt * 32 + (lane & 31)] = acc[nt][r];
      }
  }
  __syncthreads();
}
__device__ __forceinline__ void ssd_B(int vb, int tid, const float* ST, const float* DA, bf16_t* HIN) {
  const int idx = vb * 256 + tid; if (idx >= NB * 2 * 4 * 8192) return;
  const int e = idx & 8191, bdh = idx >> 13, dir = (bdh >> 2) & 1, h = bdh & 3, b = bdh >> 3;
  float run = 0.f;
  for (int k = 0; k < NCH128; ++k) {
    const int c = chain128(dir, k);
    const size_t sidx = (size_t)bdh * NCH128 + c;
    HIN[sidx * 8192 + e] = f2bf(run);
    const float dec = expf(DA[(size_t)((((b * NCH128 + c) * 2 + dir) * 4 + h) * 2) * 128 + (dir ? 0 : 127)]);
    run = dec * run + ST[sidx * 8192 + e];
  }
}
__device__ __forceinline__ void ssd_C(int item, int tid, char* smem, const bf16_t* P, const bf16_t* XBC, const bf16_t* XT, const float* DA,
                                      const bf16_t* HIN, const float* d_skip, const float* norm_g, float* CAT) {
  const int ib = item & 3, c = (item >> 2) % NCH128, b = (item >> 2) / NCH128;
  const int h = tid >> 6, lane = tid & 63, g = h >> 1, hl = lane >> 5, li = lane & 31;
  const int row0 = chunk128_row0(b, c);
  const int il = ib * 32 + li;
  float* red = (float*)smem;
  s8v cf[8];
#pragma unroll
  for (int ks = 0; ks < 8; ++ks) cf[ks] = *(const s8v*)(XBC + (size_t)(row0 + il) * 768 + 512 + g * 128 + ks * 16 + 8 * hl);
  f16v acc[2];
#pragma unroll
  for (int i = 0; i < 2; ++i)
#pragma unroll
    for (int r = 0; r < 16; ++r) acc[i][r] = 0.f;
  float aci[2];
#pragma unroll
  for (int dir = 0; dir < 2; ++dir) {
    const float* da = DA + (size_t)((((b * NCH128 + c) * 2 + dir) * 4 + h) * 2) * 128;
    aci[dir] = da[il];
    const bf16_t* hin = HIN + ((size_t)((b * 2 + dir) * 4 + h) * NCH128 + c) * 8192;
    f16v tmp[2];
#pragma unroll
    for (int i = 0; i < 2; ++i)
#pragma unroll
      for (int r = 0; r < 16; ++r) tmp[i][r] = 0.f;
#pragma unroll
    for (int ks = 0; ks < 8; ++ks)
#pragma unroll
      for (int pt = 0; pt < 2; ++pt) {
        const s8v af = *(const s8v*)(hin + (pt * 32 + li) * 128 + ks * 16 + 8 * hl);
        tmp[pt] = __builtin_amdgcn_mfma_f32_32x32x16_bf16(af, cf[ks], tmp[pt], 0, 0, 0);
      }
    const float ea = expf(aci[dir]);
#pragma unroll
    for (int pt = 0; pt < 2; ++pt)
#pragma unroll
      for (int r = 0; r < 16; ++r) acc[pt][r] += tmp[pt][r] * ea;
  }
  const bf16_t* xt = XT + (size_t)((b * NCH128 + c) * 4 + h) * 64 * 128;
  for (int jb = 0; jb < 4; ++jb) {
    f16v X;
#pragma unroll
    for (int r = 0; r < 16; ++r) X[r] = 0.f;
#pragma unroll
    for (int ks = 0; ks < 8; ++ks) {
      const s8v af = *(const s8v*)(XBC + (size_t)(row0 + jb * 32 + li) * 768 + 256 + g * 128 + ks * 16 + 8 * hl);
      X = __builtin_amdgcn_mfma_f32_32x32x16_bf16(af, cf[ks], X, 0, 0, 0);
    }
#pragma unroll
    for (int dir = 0; dir < 2; ++dir) {
      if (dir == 0 ? (jb > ib) : (jb < ib)) continue;
      const float* da = DA + (size_t)((((b * NCH128 + c) * 2 + dir) * 4 + h) * 2) * 128;
      float m[16];
#pragma unroll
      for (int q = 0; q < 4; ++q) {
        const int j0 = jb * 32 + 8 * q + 4 * hl;
        const float4 aj = *(const float4*)(da + j0), dj = *(const float4*)(da + 128 + j0);
        const float ajv[4] = {aj.x, aj.y, aj.z, aj.w}, djv[4] = {dj.x, dj.y, dj.z, dj.w};
#pragma unroll
        for (int e = 0; e < 4; ++e) {
          const int j = j0 + e;
          const bool ok = (dir == 0) ? (j <= il) : (j >= il);
          const float ex = expf(fminf(aci[dir] - ajv[e], 0.f));
          m[q * 4 + e] = ok ? X[q * 4 + e] * ex * djv[e] : 0.f;
        }
      }
#pragma unroll
      for (int s = 0; s < 2; ++s) {
        uint4 mb;
        mb.x = pack_bf2(m[8 * s + 0], m[8 * s + 1]); mb.y = pack_bf2(m[8 * s + 2], m[8 * s + 3]);
        mb.z = pack_bf2(m[8 * s + 4], m[8 * s + 5]); mb.w = pack_bf2(m[8 * s + 6], m[8 * s + 7]);
        s8v bfr; __builtin_memcpy(&bfr, &mb, 16);
#pragma unroll
        for (int pt = 0; pt < 2; ++pt) {
          const bf16_t* xr = xt + (pt * 32 + li) * 128 + jb * 32 + 16 * s + 4 * hl;
          const uint2 lo = *(const uint2*)xr, hi = *(const uint2*)(xr + 8);
          uint4 xa; xa.x = lo.x; xa.y = lo.y; xa.z = hi.x; xa.w = hi.y;
          s8v af; __builtin_memcpy(&af, &xa, 16);
          acc[pt] = __builtin_amdgcn_mfma_f32_32x32x16_bf16(af, bfr, acc[pt], 0, 0, 0);
        }
      }
    }
  }
  const float dsk = d_skip[h];
  float ssq = 0.f;
  const size_t row = (size_t)(row0 + il);
#pragma unroll
  for (int pt = 0; pt < 2; ++pt)
#pragma unroll
    for (int q = 0; q < 4; ++q) {
      const int p0 = pt * 32 + 8 * q + 4 * hl;
      const uint2 xs = *(const uint2*)(XBC + row * 768 + h * 64 + p0);
      const uint2 zz = *(const uint2*)(P + row * PLD + O_SSD + h * 64 + p0);
      const float xv[4] = {bflo(xs.x), bfhi(xs.x), bflo(xs.y), bfhi(xs.y)}, zv[4] = {bflo(zz.x), bfhi(zz.x), bflo(zz.y), bfhi(zz.y)};
#pragma unroll
      for (int e = 0; e < 4; ++e) {
        const float y = (acc[pt][q * 4 + e] + dsk * xv[e]) * siluf(zv[e]);
        acc[pt][q * 4 + e] = y; ssq += y * y;
      }
    }
  ssq += __shfl_xor(ssq, 32);
  if (lane < 32) red[h * 32 + li] = ssq;
  __syncthreads();
  const float tot = red[li] + red[32 + li] + red[64 + li] + red[96 + li];
  const float rs = rsqrtf(tot * (1.f / 256.f) + EPS);
#pragma unroll
  for (int pt = 0; pt < 2; ++pt)
#pragma unroll
    for (int q = 0; q < 4; ++q) {
      const int p0 = pt * 32 + 8 * q + 4 * hl;
      const float4 ng = *(const float4*)(norm_g + h * 64 + p0);
      float4 o; o.x = acc[pt][q * 4 + 0] * rs * ng.x; o.y = acc[pt][q * 4 + 1] * rs * ng.y; o.z = acc[pt][q * 4 + 2] * rs * ng.z; o.w = acc[pt][q * 4 + 3] * rs * ng.w;
      *(float4*)(CAT + row * DM + h * 64 + p0) = o;
    }
  __syncthreads();
}
constexpr int NCH64 = (CTX + SEQ) / 64, NCC64 = CTX / 64;
__device__ __forceinline__ int chunk64_row0(int b, int c) { return c < NCC64 ? NL + b * CTX + c * 64 : b * SEQ + (c - NCC64) * 64; }
__device__ __forceinline__ int chain64(int dir, int k) { return dir == 0 ? k : (k < NCC64 ? NCC64 - 1 - k : NCH64 - 1 - (k - NCC64)); }
__device__ __forceinline__ void gla_A(int item, int tid, char* smem, const bf16_t* P, const float* gate_w, const float* gate_b, float* ST, float* GP) {
  const int dir = item & 1, c = (item >> 1) % NCH64, b = (item >> 1) / NCH64;
  const int h = tid >> 6, lane = tid & 63, d = lane & 31, tp = lane >> 5;
  const int row0 = chunk64_row0(b, c);
  float* kbuf = (float*)(smem + h * 16384); float* gbuf = kbuf + 64 * 32;
  float gw[16];
#pragma unroll
  for (int r = 0; r < 16; ++r) gw[r] = gate_w[(dir * 16 + r) * 128 + h * 32 + d];
  const float gb = gate_b[dir * 128 + h * 32 + d];
  float lsum = 0.f;
  for (int tt = 0; tt < 32; ++tt) {
    const int t = 2 * tt + tp;
    const bf16_t* pr = P + (size_t)(row0 + t) * PLD + O_GLA;
    float z = gb;
#pragma unroll
    for (int r = 0; r < 16; ++r) z += bf2f(pr[768 + dir * 16 + r]) * gw[r];
    const float lg = logsigmoidf(z) * (1.f / 16.f);
    lsum += lg;
    kbuf[t * 32 + d] = bf2f(pr[128 + h * 32 + d]); gbuf[t * 32 + d] = expf(lg);
  }
  lsum += __shfl_xor(lsum, 32);
  const size_t sidx = (size_t)((b * 2 + dir) * 4 + h) * NCH64 + c;
  if (lane < 32) GP[sidx * 32 + d] = expf(lsum);
  __syncthreads();
  float S[32];
#pragma unroll
  for (int i = 0; i < 32; ++i) S[i] = 0.f;
#pragma unroll 4
  for (int s = 0; s < 64; ++s) {
    const int t = dir ? 63 - s : s;
    const float v = bf2f(P[(size_t)(row0 + t) * PLD + O_GLA + 256 + h * 64 + lane]);
    const float4* k4 = (const float4*)(kbuf + t * 32); const float4* g4 = (const float4*)(gbuf + t * 32);
#pragma unroll
    for (int i = 0; i < 8; ++i) {
      const float4 kk = k4[i], gg = g4[i];
      S[4 * i + 0] = gg.x * S[4 * i + 0] + kk.x * v; S[4 * i + 1] = gg.y * S[4 * i + 1] + kk.y * v;
      S[4 * i + 2] = gg.z * S[4 * i + 2] + kk.z * v; S[4 * i + 3] = gg.w * S[4 * i + 3] + kk.w * v;
    }
  }
#pragma unroll
  for (int i = 0; i < 32; ++i) ST[sidx * 2048 + i * 64 + lane] = S[i];
  __syncthreads();
}
__device__ __forceinline__ void gla_B(int vb, int tid, float* ST, const float* GP) {
  const int idx = vb * 256 + tid; if (idx >= NB * 2 * 4 * 2048) return;
  const int e = idx & 2047, bdh = idx >> 11, dk = e >> 6, dir = (bdh >> 2) & 1;
  float run = 0.f;
  for (int k = 0; k < NCH64; ++k) {
    const int c = chain64(dir, k);
    const size_t sidx = (size_t)bdh * NCH64 + c;
    const float loc = ST[sidx * 2048 + e];
    ST[sidx * 2048 + e] = run;
    run = GP[sidx * 32 + dk] * run + loc;
  }
}
__device__ __forceinline__ void gla_C(int item, int tid, char* smem, const bf16_t* P, const float* gate_w, const float* gate_b, const float* norm_g,
                                      const float* ST, float* CAT) {
  const int c = item % NCH64, b = item / NCH64;
  const int h = tid >> 6, lane = tid & 63, d = lane & 31, tp = lane >> 5;
  const int row0 = chunk64_row0(b, c);
  char* wb = smem + h * 16384;
  bf16_t* obuf = (bf16_t*)wb;
  float* gbuf = (float*)(wb + 8192);
  bf16_t* qbuf = (bf16_t*)(wb + 12288);
  bf16_t* kbuf = (bf16_t*)(wb + 14336);
  const float qs = 0.17677669529663687f;
  const float ng = norm_g[lane];
  for (int pass = 0; pass < 2; ++pass) {
    const int dir = 1 - pass;
    float gw[16];
#pragma unroll
    for (int r = 0; r < 16; ++r) gw[r] = gate_w[(dir * 16 + r) * 128 + h * 32 + d];
    const float gb = gate_b[dir * 128 + h * 32 + d];
    const size_t sidx = (size_t)((b * 2 + dir) * 4 + h) * NCH64 + c;
    float S[32];
#pragma unroll
    for (int i = 0; i < 32; ++i) S[i] = ST[sidx * 2048 + i * 64 + lane];
    for (int half = 0; half < 2; ++half) {
      for (int ss = 0; ss < 16; ++ss) {
        const int s = 2 * ss + tp; const int st = half * 32 + s; const int t = dir ? 63 - st : st;
        const bf16_t* pr = P + (size_t)(row0 + t) * PLD + O_GLA;
        float z = gb;
#pragma unroll
        for (int r = 0; r < 16; ++r) z += bf2f(pr[768 + dir * 16 + r]) * gw[r];
        gbuf[s * 32 + d] = expf(logsigmoidf(z) * (1.f / 16.f));
        qbuf[s * 32 + d] = pr[h * 32 + d]; kbuf[s * 32 + d] = pr[128 + h * 32 + d];
      }
      __syncthreads();
#pragma unroll 2
      for (int s = 0; s < 32; ++s) {
        const int st = half * 32 + s; const int t = dir ? 63 - st : st;
        const bf16_t* pr = P + (size_t)(row0 + t) * PLD + O_GLA;
        const float v = bf2f(pr[256 + h * 64 + lane]);
        float o = 0.f;
        const float4* g4 = (const float4*)(gbuf + s * 32);
        const uint4* q4 = (const uint4*)(qbuf + s * 32); const uint4* k4 = (const uint4*)(kbuf + s * 32);
#pragma unroll
        for (int i = 0; i < 4; ++i) {
          const uint4 qq = q4[i], kk = k4[i]; const float4 ga = g4[2 * i], gb4 = g4[2 * i + 1];
          float* Sp = S + 8 * i;
          Sp[0] = ga.x * Sp[0] + bflo(kk.x) * v;  o += bflo(qq.x) * Sp[0];
          Sp[1] = ga.y * Sp[1] + bfhi(kk.x) * v;  o += bfhi(qq.x) * Sp[1];
          Sp[2] = ga.z * Sp[2] + bflo(kk.y) * v;  o += bflo(qq.y) * Sp[2];
          Sp[3] = ga.w * Sp[3] + bfhi(kk.y) * v;  o += bfhi(qq.y) * Sp[3];
          Sp[4] = gb4.x * Sp[4] + bflo(kk.z) * v; o += bflo(qq.z) * Sp[4];
          Sp[5] = gb4.y * Sp[5] + bfhi(kk.z) * v; o += bfhi(qq.z) * Sp[5];
          Sp[6] = gb4.z * Sp[6] + bflo(kk.w) * v; o += bflo(qq.w) * Sp[6];
          Sp[7] = gb4.w * Sp[7] + bfhi(kk.w) * v; o += bfhi(qq.w) * Sp[7];
        }
        o *= qs;
        if (pass == 0) obuf[t * 64 + lane] = f2bf(o);
        else {
          o += bf2f(obuf[t * 64 + lane]);
          const float ssq = wave_sum(o * o);
          const float rs = rsqrtf(ssq * (1.f / 64.f) + EPS);
          CAT[(size_t)(row0 + t) * DM + 256 + h * 64 + lane] = o * rs * ng * siluf(bf2f(pr[512 + h * 64 + lane]));
        }
      }
      __syncthreads();
    }
  }
}
__device__ __forceinline__ void d_mla_norm(int vb, int tidp, char* smem, const bf16_t* P, const float* qg, const float* kvg, float* NQ, float* NKV) {
  int row = (vb * 256 + tidp) / 64, lane = tidp & 63;
  if (row >= NT) return;
  PRow pr{P + (size_t)row * PLD + O_MLA};
  float v[4], ss = 0.f;
#pragma unroll
  for (int i = 0; i < 4; ++i) { v[i] = pr[lane + 64 * i]; ss += v[i] * v[i]; }
  ss = wave_sum(ss);
  float rs = rsqrtf(ss / 256.f + EPS);
#pragma unroll
  for (int i = 0; i < 4; ++i) NQ[(size_t)row * 256 + lane + 64 * i] = v[i] * rs * qg[lane + 64 * i];
  float u[2]; ss = 0.f;
#pragma unroll
  for (int i = 0; i < 2; ++i) { u[i] = pr[256 + lane + 64 * i]; ss += u[i] * u[i]; }
  ss = wave_sum(ss);
  rs = rsqrtf(ss / 128.f + EPS);
#pragma unroll
  for (int i = 0; i < 2; ++i) NKV[(size_t)row * 128 + lane + 64 * i] = u[i] * rs * kvg[lane + 64 * i];
}
__device__ __forceinline__ void d_mla_rope(int vb, int tidp, char* smem, const bf16_t* P, float* Q, const float* KVraw, float* K, float* V) {
  size_t idx = (size_t)vb * 256 + tidp;
  if (idx >= (size_t)NT * 4 * 16) return;
  int r = (int)(idx / 64), h = (int)((idx / 16) % 4), i = (int)(idx % 16);
  float cs = 1.f, sn = 0.f;
  if (r < NL) {
    int t = r % SEQ; int rowi = t / GRIDW, coli = t % GRIDW;
    int f = i & 7;
    float inv = powf(10000.f, -(float)(2 * f) / 16.f);
    float ang = (i < 8 ? (float)rowi : (float)coli) * inv;
    cs = cosf(ang); sn = sinf(ang);
  }
  float* q = Q + (size_t)r * 384 + h * 96 + 64;
  float x1 = q[i], x2 = q[i + 16];
  q[i] = x1 * cs - x2 * sn; q[i + 16] = x1 * sn + x2 * cs;
  PRow kr{P + (size_t)r * PLD + O_MLA + 384};
  float k1 = kr[i], k2 = kr[i + 16];
  float* kk = K + (size_t)r * 384 + h * 96;
  kk[64 + i] = k1 * cs - k2 * sn; kk[64 + 16 + i] = k1 * sn + k2 * cs;
  const float* kv = KVraw + (size_t)r * 512 + h * 128;
  for (int j = i; j < 64; j += 16) { kk[j] = kv[j]; V[(size_t)r * 256 + h * 64 + j] = kv[64 + j]; }
}
__device__ __forceinline__ void d_attn(int vb, int tidp, char* smem, const float* Q, const float* K, const float* V, float* CAT, int row0, int nrows) {
  int wv = vb * 4 + (tidp >> 6); int nrb = nrows / 32; if (wv >= nrb * 4) return;
  int lane = tidp & 63, sub = lane & 1;
  int h = wv / nrb; int r = row0 + (wv % nrb) * 32 + (lane >> 1);
  float q[48], o[32];
  const float scale = 0.10206207261596575f;
#pragma unroll
  for (int i = 0; i < 48; ++i) q[i] = Q[(size_t)r * 384 + h * 96 + sub * 48 + i] * scale;
#pragma unroll
  for (int i = 0; i < 32; ++i) o[i] = 0.f;
  float m = -1e30f, l = 0.f;
  int b, nseg; int seg0[2], segn[2];
  if (r < NL) { b = r / SEQ; nseg = 2; seg0[0] = b * SEQ; segn[0] = SEQ; seg0[1] = NL + b * CTX; segn[1] = CTX; }
  else { b = (r - NL) / CTX; nseg = 1; seg0[0] = NL + b * CTX; segn[0] = CTX; seg0[1] = 0; segn[1] = 0; }
  for (int sg = 0; sg < nseg; ++sg)
    for (int j = 0; j < segn[sg]; ++j) {
      const float* kp = K + (size_t)(seg0[sg] + j) * 384 + h * 96 + sub * 48;
      const float* vp = V + (size_t)(seg0[sg] + j) * 256 + h * 64 + sub * 32;
      float s = 0.f;
#pragma unroll
      for (int i = 0; i < 48; ++i) s += q[i] * kp[i];
      s += __shfl_xor(s, 1);
      float mn = fmaxf(m, s);
      float al = expf(m - mn), pp = expf(s - mn);
      l = l * al + pp;
#pragma unroll
      for (int i = 0; i < 32; ++i) o[i] = o[i] * al + pp * vp[i];
      m = mn;
    }
  float il = 1.f / l;
#pragma unroll
  for (int i = 0; i < 32; ++i) CAT[(size_t)r * DM + 512 + h * 64 + sub * 32 + i] = o[i] * il;
}
__device__ __forceinline__ void d_s5_scan(int vb, int tidp, char* smem, const bf16_t* P, const float* a_re, const float* a_im, const float* log_dt,
                                                const float* b_re, const float* b_im, const float* c_re, const float* c_im,
                                                float* CAT, int dir) {
  int wv = vb * 4 + (tidp >> 6); if (wv >= NB * 16) return; int b = wv / 16, g = wv % 16, n = tidp & 63;
  float lre = fminf(a_re[(dir * 16 + g) * 64 + n], -1e-4f), lim = a_im[(dir * 16 + g) * 64 + n];
  float step = expf(log_dt[dir * 16 + g]);
  float er = expf(lre * step);
  float ar = er * cosf(lim * step), ai = er * sinf(lim * step);
  float nr = ar - 1.f, ni = ai, den = lre * lre + lim * lim;
  float cr = (nr * lre + ni * lim) / den, ci = (ni * lre - nr * lim) / den;
  float bbr[16], bbi[16], cmr[16], cmi[16];
#pragma unroll
  for (int c = 0; c < 16; ++c) {
    float br = b_re[(g * 64 + n) * 16 + c], bi = b_im[(g * 64 + n) * 16 + c];
    bbr[c] = cr * br - ci * bi; bbi[c] = cr * bi + ci * br;
    cmr[c] = c_re[((dir * 16 + g) * 16 + c) * 64 + n]; cmi[c] = c_im[((dir * 16 + g) * 16 + c) * 64 + n];
  }
  float hr = 0.f, hi = 0.f;
  for (int s = 0; s < CTX + SEQ; ++s) {
    int r;
    if (s < CTX) r = NL + b * CTX + (dir ? CTX - 1 - s : s);
    else { int t = s - CTX; r = b * SEQ + (dir ? SEQ - 1 - t : t); }
    PRow u{P + (size_t)r * PLD + O_S5 + g * 16};
    float bur = 0.f, bui = 0.f;
#pragma unroll
    for (int c = 0; c < 16; ++c) { float uc = u[c]; bur += uc * bbr[c]; bui += uc * bbi[c]; }
    float nhr = ar * hr - ai * hi + bur, nhi = ar * hi + ai * hr + bui;
    hr = nhr; hi = nhi;
    float yv = 0.f;
#pragma unroll
    for (int c = 0; c < 16; ++c) {
      float y = wave_sum(hr * cmr[c] - hi * cmi[c]);
      if (n == c) yv = y;
    }
    if (n < 16) { float* o = CAT + (size_t)r * DM + 768 + g * 16 + n; if (dir) *o += yv; else *o = yv; }
  }
}
__device__ __forceinline__ void d_s5_gelu(int vb, int tidp, char* smem, const bf16_t* P, const float* d_skip, float* CAT, int nrows) {
  size_t idx = (size_t)vb * 256 + tidp;
  if (idx >= (size_t)nrows * 256) return;
  int r = (int)(idx >> 8), c = (int)(idx & 255);
  float* o = CAT + (size_t)r * DM + 768 + c;
  *o = geluf(*o + d_skip[c] * bf2f(P[(size_t)r * PLD + O_S5 + c]));
}
__device__ __forceinline__ void d_s5_glu(int vb, int tidp, char* smem, const float* T, const float* glu_b, float* CAT, int nrows) {
  size_t idx = (size_t)vb * 256 + tidp;
  if (idx >= (size_t)nrows * 256) return;
  int r = (int)(idx >> 8), c = (int)(idx & 255);
  float* o = CAT + (size_t)r * DM + 768 + c;
  *o = *o * sigmoidf_(T[idx] + glu_b[c]);
}
struct S5Consts { float ar, ai; float bbr[16], bbi[16]; };
__device__ __forceinline__ void s5_consts(S5Consts& k, int dir, int g, int n, const float* a_re, const float* a_im, const float* log_dt,
                                          const float* b_re, const float* b_im) {
  const float lre = fminf(a_re[(dir * 16 + g) * 64 + n], -1e-4f), lim = a_im[(dir * 16 + g) * 64 + n];
  const float step = expf(log_dt[dir * 16 + g]);
  const float er = expf(lre * step);
  k.ar = er * cosf(lim * step); k.ai = er * sinf(lim * step);
  const float nr = k.ar - 1.f, ni = k.ai, den = lre * lre + lim * lim;
  const float cr = (nr * lre + ni * lim) / den, ci = (ni * lre - nr * lim) / den;
#pragma unroll
  for (int c = 0; c < 16; ++c) {
    const float br = b_re[(g * 64 + n) * 16 + c], bi = b_im[(g * 64 + n) * 16 + c];
    k.bbr[c] = cr * br - ci * bi; k.bbi[c] = cr * bi + ci * br;
  }
}
__device__ __forceinline__ void s5_load_u(float* u, const bf16_t* P, int r, int g) {
  const uint4* p4 = (const uint4*)(P + (size_t)r * PLD + O_S5 + g * 16);
  const uint4 a = p4[0], b = p4[1];
  u[0] = bflo(a.x); u[1] = bfhi(a.x); u[2] = bflo(a.y); u[3] = bfhi(a.y); u[4] = bflo(a.z); u[5] = bfhi(a.z); u[6] = bflo(a.w); u[7] = bfhi(a.w);
  u[8] = bflo(b.x); u[9] = bfhi(b.x); u[10] = bflo(b.y); u[11] = bfhi(b.y); u[12] = bflo(b.z); u[13] = bfhi(b.z); u[14] = bflo(b.w); u[15] = bfhi(b.w);
}
__device__ __forceinline__ void s5_cct(int vb, int tid, const float* c_re, const float* c_im, bf16_t* CCT) {
  const int idx = vb * 256 + tid; if (idx >= 2 * 16 * 16 * 128) return;
  const int np = idx & 127, dgc = idx >> 7;
  CCT[idx] = f2bf(np < 64 ? c_re[dgc * 64 + np] : -c_im[dgc * 64 + np - 64]);
}
__device__ __forceinline__ void s5_A(int item, int tid, const bf16_t* P, const float* a_re, const float* a_im, const float* log_dt,
                                     const float* b_re, const float* b_im, float2* END) {
  const int gq = item & 3, dir = (item >> 2) & 1, c = (item >> 3) % NCH64, b = (item >> 3) / NCH64;
  const int g = gq * 4 + (tid >> 6), n = tid & 63;
  const int row0 = chunk64_row0(b, c);
  S5Consts k; s5_consts(k, dir, g, n, a_re, a_im, log_dt, b_re, b_im);
  float hr = 0.f, hi = 0.f;
#pragma unroll 4
  for (int s = 0; s < 64; ++s) {
    const int t = dir ? 63 - s : s;
    float u[16]; s5_load_u(u, P, row0 + t, g);
    float bur = 0.f, bui = 0.f;
#pragma unroll
    for (int cc = 0; cc < 16; ++cc) { bur += u[cc] * k.bbr[cc]; bui += u[cc] * k.bbi[cc]; }
    const float nhr = k.ar * hr - k.ai * hi + bur, nhi = k.ar * hi + k.ai * hr + bui;
    hr = nhr; hi = nhi;
  }
  END[((size_t)((b * 2 + dir) * 16 + g) * NCH64 + c) * 64 + n] = make_float2(hr, hi);
}
__device__ __forceinline__ void s5_B(int vb, int tid, const float* a_re, const float* a_im, const float* log_dt, float2* END) {
  const int idx = vb * 256 + tid; if (idx >= NB * 2 * 16 * 64) return;
  const int n = idx & 63, g = (idx >> 6) & 15, dir = (idx >> 10) & 1;
  const float lre = fminf(a_re[(dir * 16 + g) * 64 + n], -1e-4f), lim = a_im[(dir * 16 + g) * 64 + n];
  const float step = expf(log_dt[dir * 16 + g]) * 64.f;
  const float er = expf(lre * step);
  const float ar = er * cosf(lim * step), ai = er * sinf(lim * step);
  float rr = 0.f, ri = 0.f;
  float2* base = END + (size_t)(idx >> 6) * NCH64 * 64 + n;
  for (int kk = 0; kk < NCH64; ++kk) {
    const int c = chain64(dir, kk);
    const float2 loc = base[(size_t)c * 64];
    base[(size_t)c * 64] = make_float2(rr, ri);
    const float nr = ar * rr - ai * ri + loc.x, ni = ar * ri + ai * rr + loc.y;
    rr = nr; ri = ni;
  }
}
__device__ __forceinline__ void s5_C(int item, int tid, char* smem, const bf16_t* P, const float* a_re, const float* a_im, const float* log_dt,
                                     const float* b_re, const float* b_im, const bf16_t* CCT, const float* d_skip, const bf16_t* WT_GLU,
                                     const float* glu_b, const float2* SIN, float* CAT) {
  const int c = item % NCH64, b = item / NCH64;
  const int w = tid >> 6, lane = tid & 63, n = lane;
  const int row0 = chunk64_row0(b, c);
  bf16_t* HB = (bf16_t*)(smem + w * 8192);
  char* Y = smem + 32768;
  for (int gi = 0; gi < 4; ++gi) {
    const int g = w * 4 + gi;
    f4v acc[4];
#pragma unroll
    for (int i = 0; i < 4; ++i) acc[i] = (f4v){0.f, 0.f, 0.f, 0.f};
    for (int dir = 0; dir < 2; ++dir) {
      S5Consts k; s5_consts(k, dir, g, n, a_re, a_im, log_dt, b_re, b_im);
      const float2 h0 = SIN[((size_t)((b * 2 + dir) * 16 + g) * NCH64 + c) * 64 + n];
      float hr = h0.x, hi = h0.y;
      for (int half = 0; half < 2; ++half) {
#pragma unroll 4
        for (int s = 0; s < 32; ++s) {
          const int st = half * 32 + s; const int t = dir ? 63 - st : st;
          float u[16]; s5_load_u(u, P, row0 + t, g);
          float bur = 0.f, bui = 0.f;
#pragma unroll
          for (int cc = 0; cc < 16; ++cc) { bur += u[cc] * k.bbr[cc]; bui += u[cc] * k.bbi[cc]; }
          const float nhr = k.ar * hr - k.ai * hi + bur, nhi = k.ar * hi + k.ai * hr + bui;
          hr = nhr; hi = nhi;
          HB[(t & 31) * 128 + n] = f2bf(hr); HB[(t & 31) * 128 + 64 + n] = f2bf(hi);
        }
        __syncthreads();
        const int thalf = dir ? 1 - half : half;
        const bf16_t* cc = CCT + (size_t)((dir * 16 + g) * 16 + (lane & 15)) * 128;
#pragma unroll
        for (int ks = 0; ks < 4; ++ks) {
          const s8v bfr = *(const s8v*)(cc + ks * 32 + (lane >> 4) * 8);
#pragma unroll
          for (int tt = 0; tt < 2; ++tt) {
            const s8v af = *(const s8v*)(HB + (tt * 16 + (lane & 15)) * 128 + ks * 32 + (lane >> 4) * 8);
            acc[thalf * 2 + tt] = __builtin_amdgcn_mfma_f32_16x16x32_bf16(af, bfr, acc[thalf * 2 + tt], 0, 0, 0);
          }
        }
        __syncthreads();
      }
    }
    const int cch = g * 16 + (lane & 15);
    const float dsk = d_skip[cch];
#pragma unroll
    for (int i = 0; i < 4; ++i)
#pragma unroll
      for (int r = 0; r < 4; ++r) {
        const int t = i * 16 + (lane >> 4) * 4 + r;
        const float y = geluf(acc[i][r] + dsk * bf2f(P[(size_t)(row0 + t) * PLD + O_S5 + cch]));
        *(bf16_t*)(Y + t * 512 + (((cch >> 3) ^ (t & 31)) << 4) + (cch & 7) * 2) = f2bf(y);
      }
  }
  __syncthreads();
  f16v ga[2][2];
#pragma unroll
  for (int i = 0; i < 2; ++i)
#pragma unroll
    for (int j = 0; j < 2; ++j)
#pragma unroll
      for (int r = 0; r < 16; ++r) ga[i][j][r] = 0.f;
#pragma unroll 4
  for (int ks = 0; ks < 16; ++ks) {
    s8v af[2], bfr[2];
    const int ch = ks * 2 + (lane >> 5);
#pragma unroll
    for (int i = 0; i < 2; ++i) {
      const int t = i * 32 + (lane & 31);
      af[i] = *(const s8v*)(Y + t * 512 + ((ch ^ (t & 31)) << 4));
      bfr[i] = *(const s8v*)(WT_GLU + (size_t)(w * 64 + i * 32 + (lane & 31)) * 256 + ch * 8);
    }
#pragma unroll
    for (int i = 0; i < 2; ++i)
#pragma unroll
      for (int j = 0; j < 2; ++j) ga[i][j] = __builtin_amdgcn_mfma_f32_32x32x16_bf16(af[i], bfr[j], ga[i][j], 0, 0, 0);
  }
#pragma unroll
  for (int i = 0; i < 2; ++i)
#pragma unroll
    for (int j = 0; j < 2; ++j) {
      const int col = w * 64 + j * 32 + (lane & 31);
      const float gbias = glu_b[col];
#pragma unroll
      for (int r = 0; r < 16; ++r) {
        const int t = i * 32 + (r & 3) + 8 * (r >> 2) + 4 * (lane >> 5);
        const float y = bf2f(*(const bf16_t*)(Y + t * 512 + (((col >> 3) ^ (t & 31)) << 4) + (col & 7) * 2));
        CAT[(size_t)(row0 + t) * DM + 768 + col] = y * sigmoidf_(ga[i][j][r] + gbias);
      }
    }
  __syncthreads();
}
__device__ __forceinline__ void d_resid(int vb, int tidp, char* smem, float* H, const float* X, const float* mod, int imod, int nrows) {
  size_t idx = (size_t)vb * 256 + tidp;
  if (idx >= (size_t)nrows * DM) return;
  int r = (int)(idx >> 10), c = (int)(idx & 1023);
  H[idx] += mod[row_mod(r) * NMOD * DM + imod * DM + c] * X[idx];
}
__device__ __forceinline__ void d_peer_topk(int vb, int tidp, char* smem, const float* QP, const float* sub_keys, int* EIDX, float* GATE) {
  int half = tidp >> 7; smem += half * 4096;
  float* s1 = (float*)smem; float* s2 = s1 + 128; float* v1 = s2 + 128; float* v2 = v1 + 16;
  int* i1 = (int*)(v2 + 16); int* i2 = i1 + 16; float* cand = (float*)(i2 + 16); float* best = cand + 256; int* bidx = (int*)(best + 16);
  int item = vb * 2 + half; int row = item >> 3, h = item & 7, j = tidp & 127;
  const float* q = QP + (size_t)row * DM + h * 128;
  const float* k1 = sub_keys + ((size_t)(0 * 8 + h) * 128 + j) * 64;
  const float* k2 = sub_keys + ((size_t)(1 * 8 + h) * 128 + j) * 64;
  float a = 0.f, b = 0.f;
  for (int d = 0; d < 64; ++d) { a += q[d] * k1[d]; b += q[64 + d] * k2[d]; }
  s1[j] = a; s2[j] = b;
  __syncthreads();
  int ra = 0, rb = 0;
  for (int i = 0; i < 128; ++i) {
    float x = s1[i], y = s2[i];
    ra += (x > a) || (x == a && i < j);
    rb += (y > b) || (y == b && i < j);
  }
  if (ra < 16) { v1[ra] = a; i1[ra] = j; }
  if (rb < 16) { v2[rb] = b; i2[rb] = j; }
  __syncthreads();
  float c0 = v1[j >> 4] + v2[j & 15], c1 = v1[(j + 128) >> 4] + v2[(j + 128) & 15];
  cand[j] = c0; cand[j + 128] = c1;
  __syncthreads();
  int r0 = 0, r1 = 0;
  for (int i = 0; i < 256; ++i) {
    float x = cand[i];
    r0 += (x > c0) || (x == c0 && i < j);
    r1 += (x > c1) || (x == c1 && i < j + 128);
  }
  if (r0 < 16) { best[r0] = c0; bidx[r0] = i1[j >> 4] * 128 + i2[j & 15]; }
  if (r1 < 16) { best[r1] = c1; bidx[r1] = i1[(j + 128) >> 4] * 128 + i2[(j + 128) & 15]; }
  __syncthreads();
  if (j < 16) {
    float mx = best[0];
    float sum = 0.f;
    for (int i = 0; i < 16; ++i) sum += expf(best[i] - mx);
    GATE[(size_t)row * 128 + h * 16 + j] = expf(best[j] - mx) / sum;
    EIDX[(size_t)row * 128 + h * 16 + j] = bidx[j];
  }
  __syncthreads();
}
__device__ __forceinline__ void d_peer_gather(int vb, int tidp, char* smem, const float* GFFl, const int* EIDX, const float* GATE, const float* U, const float* Vt,
                                                     const float* mod, float* H) {
  float* f = (float*)smem; float* wgt = f + 1024; int* eid = (int*)(wgt + 128); float* red = (float*)(eid + 128);
  int row = vb, tid = tidp, lane = tid & 63, w = tid >> 6;
  {
    float hv[4], ss = 0.f;
#pragma unroll
    for (int i = 0; i < 4; ++i) { hv[i] = H[(size_t)row * DM + tid + 256 * i]; ss += hv[i] * hv[i]; }
    ss = wave_sum(ss);
    if (lane == 0) red[w] = ss;
    if (tid < 128) eid[tid] = EIDX[(size_t)row * 128 + tid];
    __syncthreads();
    const float rs = rsqrtf((red[0] + red[1] + red[2] + red[3]) * (1.f / DM) + EPS);
    const float* gg = GFFl + row_mod(row) * DM; const float* sh = mod + row_mod(row) * NMOD * DM + 3 * DM;
#pragma unroll
    for (int i = 0; i < 4; ++i) { const int k = tid + 256 * i; f[k] = hv[i] * rs * gg[k] + sh[k]; }
  }
  __syncthreads();
  for (int kk = 0; kk < 32; ++kk) {
    int k = w * 32 + kk; const float* u = U + (size_t)eid[k] * DM;
    float s = 0.f;
#pragma unroll
    for (int i = 0; i < 16; ++i) s += f[lane + 64 * i] * u[lane + 64 * i];
    s = wave_sum(s);
    if (lane == 0) wgt[k] = GATE[(size_t)row * 128 + k] * geluf(s);
  }
  __syncthreads();
  float acc[4] = {0.f, 0.f, 0.f, 0.f};
  for (int k = 0; k < 128; ++k) {
    const float* v = Vt + (size_t)eid[k] * DM; float wk = wgt[k];
#pragma unroll
    for (int i = 0; i < 4; ++i) acc[i] += wk * v[tid + 256 * i];
  }
  const float* mm = mod + row_mod(row) * NMOD * DM + 5 * DM;
#pragma unroll
  for (int i = 0; i < 4; ++i) { int c = tid + 256 * i; H[(size_t)row * DM + c] += mm[c] * acc[i]; }
  __syncthreads();
}
__device__ __forceinline__ void d_final(int vb, int tidp, char* smem, const float* H, const float* g, float* out) {
  int row = (vb * 256 + tidp) / 64, lane = tidp & 63;
  if (row >= NL) return;
  const float* h = H + (size_t)row * DM;
  float ss = 0.f;
  for (int k = lane; k < DM; k += 64) ss += h[k] * h[k];
  ss = wave_sum(ss);
  float rs = rsqrtf(ss / DM + EPS);
  for (int k = lane; k < DM; k += 64) out[(size_t)row * DM + k] = h[k] * rs * g[k];
}

constexpr int LDS_BYTES = 65536 + 256;
#ifdef EMU_STOP_L0C
static float* g_dbg_cat = nullptr;
#endif
struct Params {
  const float* in[38];
  float* out;
  char* ws;
};
#ifdef EMU
#define TID() ((int)threadIdx.x)
#else
__device__ __forceinline__ int opaque_tid() { int t = threadIdx.x; asm volatile("" : "+v"(t)); return t; }
#define TID() opaque_tid()
#endif
#define FOR_VB(n) for (int vb = blockIdx.x, nvb_ = (n); vb < nvb_; vb += gridDim.x)
__device__ __forceinline__ int cdivd(size_t a, size_t b) { return (int)((a + b - 1) / b); }

__global__ void __launch_bounds__(256, 1) mega(Params p) {
#ifdef EMU
  char* smem = emu_block_smem();
#else
  extern __shared__ __attribute__((aligned(16))) char smem[];
#endif
  const float* x = p.in[0];       const float* c = p.in[1];
  const float* ctx = p.in[2];     const float* c_ctx = p.in[3];
  const float* ada_w = p.in[4];   const float* ada_b = p.in[5];
  const float* norm_mix_g = p.in[6]; const float* norm_ffn_g = p.in[7];
  const float* w_in = p.in[8];    const float* w_out = p.in[9];
  const float* ssd_conv_w = p.in[10]; const float* ssd_conv_b = p.in[11];
  const float* ssd_a_log = p.in[12];  const float* ssd_dt_bias = p.in[13];
  const float* ssd_d = p.in[14];  const float* ssd_norm_g = p.in[15];
  const float* gla_gate_w = p.in[16]; const float* gla_gate_b = p.in[17];
  const float* gla_norm_g = p.in[18]; const float* mla_q_norm_g = p.in[19];
  const float* mla_w_uq = p.in[20];   const float* mla_kv_norm_g = p.in[21];
  const float* mla_w_ukv = p.in[22];  const float* s5_a_re = p.in[23];
  const float* s5_a_im = p.in[24];    const float* s5_log_dt = p.in[25];
  const float* s5_b_re = p.in[26];    const float* s5_b_im = p.in[27];
  const float* s5_c_re = p.in[28];    const float* s5_c_im = p.in[29];
  const float* s5_d = p.in[30];       const float* s5_glu_w = p.in[31];
  const float* s5_glu_b = p.in[32];   const float* peer_w_q = p.in[33];
  const float* peer_sub_keys = p.in[34]; const float* peer_u = p.in[35];
  const float* peer_v = p.in[36];     const float* final_norm_g = p.in[37];
  float* out = p.out;

  char* wp = p.ws; size_t off = 16384;
#ifndef EMU
  const XBar xbar = xbar_init((unsigned*)p.ws, (volatile unsigned*)(smem + 65536));
  cooperative_groups::this_grid().sync();
#endif
  auto carve = [&](size_t nbytes) { char* q = wp + off; off += ((nbytes + 255) / 256) * 256; return q; };
  float* MOD = (float*)carve((size_t)2 * 3 * NMOD * DM * 4);
  float* H = (float*)carve((size_t)NT * DM * 4);
  bf16_t* P = (bf16_t*)carve((size_t)NT * PLD * 2);
  float* PF = (float*)carve((size_t)NB * 2 * 4 * NCH128 * 8192 * 6);
  bf16_t* XBC = (bf16_t*)carve((size_t)NT * 768 * 2);
  bf16_t* XT = (bf16_t*)carve((size_t)NT * 256 * 2);
  float* SSD_DA = (float*)carve((size_t)NB * NCH128 * 2 * 4 * 2 * 128 * 4);

  float* CAT = (float*)carve((size_t)NT * DM * 4);
  float* GLA_ST = (float*)carve((size_t)NB * 2 * 4 * NCH64 * 2048 * 4);
  float* GLA_GP = (float*)carve((size_t)NB * 2 * 4 * NCH64 * 32 * 4);
  float* Q = (float*)carve((size_t)NT * 384 * 4);
  float* K = (float*)carve((size_t)NT * 384 * 4);
  float* V = (float*)carve((size_t)NT * 256 * 4);
  float* SCR = (float*)carve((size_t)NT * (256 + 128 + 512) * 4);
  bf16_t* WT_IN = (bf16_t*)carve((size_t)2 * 2560 * DM * 2);
  bf16_t* WT_OUT = (bf16_t*)carve((size_t)2 * DM * DM * 2);
  bf16_t* WT_PQ = (bf16_t*)carve((size_t)2 * DM * DM * 2);
  bf16_t* WT_UQ = (bf16_t*)carve((size_t)2 * 384 * 256 * 2);
  bf16_t* WT_UKV = (bf16_t*)carve((size_t)2 * 512 * 128 * 2);
  bf16_t* WT_GLU = (bf16_t*)carve((size_t)2 * 256 * 256 * 2);
  float2* S5_ST = (float2*)carve((size_t)NB * 2 * 16 * NCH64 * 64 * 8);
  bf16_t* S5_CCT = (bf16_t*)carve((size_t)2 * 2 * 16 * 16 * 128 * 2);
  float* TIN = (float*)carve((size_t)2 * 3 * 2560 * 4);
  float* TPQ = (float*)carve((size_t)2 * 3 * DM * 4);
  float* GIN = (float*)carve((size_t)2 * 3 * DM * 4);
  float* GFF = (float*)carve((size_t)2 * 3 * DM * 4);
  float* SSD_ST = PF; bf16_t* SSD_HIN = (bf16_t*)(PF + (size_t)NB * 2 * 4 * NCH128 * 8192);
  float* QP = CAT;
  float* NQ = SCR; float* NKV = SCR + (size_t)NT * 256; float* KVraw = NKV + (size_t)NT * 128;
  float* T = SCR; int* EIDX = (int*)SCR; float* GATE = SCR + (size_t)NT * 128;

  FOR_VB(cdivd(2 * 3 * NMOD * DM, 256)) d_mod(vb, TID(), smem, c, c_ctx, ada_w, ada_b, MOD);
  FOR_VB(cdivd((size_t)NT * DM, 256)) d_copy_h(vb, TID(), smem, x, ctx, H);
  {
    const int n_in = 16 * 40, n_sq = 16 * 16, n_uq = 4 * 6, n_ukv = 2 * 8, n_glu = 4 * 4;
    const int per_l = n_in + 2 * n_sq + n_uq + n_ukv + n_glu;
    FOR_VB(2 * per_l) {
      int l = vb / per_l, v = vb % per_l; int tid = TID();
      if (v < n_in) { d_transpose_w(v, tid, smem, w_in + (size_t)l * DM * DIN, WT_IN + (size_t)l * 2560 * DM, DM, DIN, 2560); continue; }
      v -= n_in;
      if (v < n_sq) { d_transpose_w(v, tid, smem, w_out + (size_t)l * DM * DM, WT_OUT + (size_t)l * DM * DM, DM, DM, DM); continue; }
      v -= n_sq;
      if (v < n_sq) { d_transpose_w(v, tid, smem, peer_w_q + (size_t)l * DM * DM, WT_PQ + (size_t)l * DM * DM, DM, DM, DM); continue; }
      v -= n_sq;
      if (v < n_uq) { d_transpose_w(v, tid, smem, mla_w_uq + (size_t)l * 256 * 384, WT_UQ + (size_t)l * 384 * 256, 256, 384, 384); continue; }
      v -= n_uq;
      if (v < n_ukv) { d_transpose_w(v, tid, smem, mla_w_ukv + (size_t)l * 128 * 512, WT_UKV + (size_t)l * 512 * 128, 128, 512, 512); continue; }
      v -= n_ukv;
      d_transpose_w(v, tid, smem, s5_glu_w + (size_t)l * 65536, WT_GLU + (size_t)l * 65536, 256, 256, 256);
    }
  }
  FOR_VB(2 * 256) { int l = vb / 256; s5_cct(vb % 256, TID(), s5_c_re + l * 32768, s5_c_im + l * 32768, S5_CCT + (size_t)l * 65536); }
  GRID_SYNC();
  {
    const int n_tin = cdivd(3 * DIN, 256), n_tpq = cdivd(3 * DM, 256), n_g = cdivd(3 * DM, 256);
    const int per_l = n_tin + n_tpq + 2 * n_g;
    FOR_VB(2 * per_l) {
      int l = vb / per_l, v = vb % per_l; int tid = TID();
      const float* mod = MOD + (size_t)l * 3 * NMOD * DM;
      if (v < n_tin) { d_shiftvec(v, tid, w_in + (size_t)l * DM * DIN, DIN, mod, 0, TIN + l * 3 * 2560, 2560); continue; }
      v -= n_tin;
      if (v < n_tpq) { d_shiftvec(v, tid, peer_w_q + (size_t)l * DM * DM, DM, mod, 3, TPQ + l * 3 * DM, DM); continue; }
      v -= n_tpq;
      if (v < n_g) { d_gainvec(v, tid, norm_mix_g + l * DM, mod, 1, GIN + l * 3 * DM); continue; }
      v -= n_g;
      d_gainvec(v, tid, norm_ffn_g + l * DM, mod, 4, GFF + l * 3 * DM);
    }
  }
  GRID_SYNC();
#pragma unroll 1
  for (int l = 0; l < 2; ++l) {
    const float* mod = MOD + (size_t)l * 3 * NMOD * DM;
    const int nact = (l == 0) ? NT : NL;
    FOR_VB(20 * (NT / 128)) {
      int tid = TID(); int mt = vb / 20, nt = vb % 20; int m0 = mt * 128;
      EpiStoreBf16 epi{P, PLD, TIN + l * 3 * 2560, 2560};
      gemm128<true, true>(tid, smem, H, DM, GIN + l * 3 * DM + row_mod(m0) * DM, WT_IN + (size_t)l * 2560 * DM, DM, DM, m0, nt * 128, epi);
    }
    GRID_SYNC();
    FOR_VB(NB * NCH128 * 4) ssd_A(vb, TID(), smem, P, ssd_conv_w + l * 5 * 768, ssd_conv_b + l * 768, ssd_a_log + l * 8, ssd_dt_bias + l * 8, XBC, XT, SSD_DA, SSD_ST);
    FOR_VB(NB * NCH64 * 8) s5_A(vb, TID(), P, s5_a_re + l * 2048, s5_a_im + l * 2048, s5_log_dt + l * 32, s5_b_re + l * 16384, s5_b_im + l * 16384, S5_ST);
    FOR_VB(NB * NCH64 * 2) gla_A(vb, TID(), smem, P, gla_gate_w + l * 2 * 16 * 128, gla_gate_b + l * 256, GLA_ST, GLA_GP);
    FOR_VB(cdivd((size_t)NT * 64, 256)) d_mla_norm(vb, TID(), smem, P, mla_q_norm_g + l * 256, mla_kv_norm_g + l * 128, NQ, NKV);
    GRID_SYNC();
    FOR_VB(3 * (NT / 128)) {
      int tid = TID(); int mt = vb / 3, nt = vb % 3;
      EpiStoreF32 epi{Q, 384, 384, nullptr, 0};
      gemm128<true, false>(tid, smem, NQ, 256, nullptr, WT_UQ + (size_t)l * 384 * 256, 256, 256, mt * 128, nt * 128, epi);
    }
    FOR_VB(4 * (NT / 128)) {
      int tid = TID(); int mt = vb / 4, nt = vb % 4;
      EpiStoreF32 epi{KVraw, 512, 512, nullptr, 0};
      gemm128<true, false>(tid, smem, NKV, 128, nullptr, WT_UKV + (size_t)l * 512 * 128, 128, 128, mt * 128, nt * 128, epi);
    }
    GRID_SYNC();
    FOR_VB(cdivd((size_t)NT * 64, 256)) d_mla_rope(vb, TID(), smem, P, Q, KVraw, K, V);
    FOR_VB(NB * 2 * 4 * 8192 / 256) ssd_B(vb, TID(), SSD_ST, SSD_DA, SSD_HIN);
    FOR_VB(NB * 2 * 4 * 2048 / 256) gla_B(vb, TID(), GLA_ST, GLA_GP);
    FOR_VB(NB * 2 * 16 * 64 / 256) s5_B(vb, TID(), s5_a_re + l * 2048, s5_a_im + l * 2048, s5_log_dt + l * 32, S5_ST);
    GRID_SYNC();
    {
      const int n_ssd = NB * NCH128 * 4, n_gla = NB * NCH64, n_s5 = NB * NCH64, n_att = (nact / 32 * 4 + 3) / 4;
      FOR_VB(n_ssd + n_gla + n_s5 + n_att) {
        int v = vb;
        if (v < n_ssd) { if (l == 0 || ((v >> 2) % NCH128) >= NCC128) ssd_C(v, TID(), smem, P, XBC, XT, SSD_DA, SSD_HIN, ssd_d + l * 4, ssd_norm_g + l * 256, CAT); continue; }
        v -= n_ssd;
        if (v < n_gla) { if (l == 0 || (v % NCH64) >= NCC64) gla_C(v, TID(), smem, P, gla_gate_w + l * 2 * 16 * 128, gla_gate_b + l * 256, gla_norm_g + l * 64, GLA_ST, CAT); continue; }
        v -= n_gla;
        if (v < n_s5) { if (l == 0 || (v % NCH64) >= NCC64) s5_C(v, TID(), smem, P, s5_a_re + l * 2048, s5_a_im + l * 2048, s5_log_dt + l * 32, s5_b_re + l * 16384, s5_b_im + l * 16384,
                                  S5_CCT + (size_t)l * 65536, s5_d + l * 256, WT_GLU + (size_t)l * 65536, s5_glu_b + l * 256, S5_ST, CAT); continue; }
        v -= n_s5;
#ifndef EMU_NO_ATTN
        d_attn(v, TID(), smem, Q, K, V, CAT, 0, nact);
#endif
      }
      GRID_SYNC();
    }
#ifdef EMU_STOP_L0C
    g_dbg_cat = CAT; return;
#endif
    FOR_VB(8 * (nact / 128)) {
      int tid = TID(); int mt = vb / 8, nt = vb % 8;
      EpiResid epi{H, mod, 2};
      gemm128<true, false>(tid, smem, CAT, DM, nullptr, WT_OUT + (size_t)l * DM * DM, DM, DM, mt * 128, nt * 128, epi);
    }
    GRID_SYNC();
    FOR_VB(8 * (nact / 128)) {
      int tid = TID(); int mt = vb / 8, nt = vb % 8; int m0 = mt * 128;
      EpiStoreF32 epi{QP, DM, DM, TPQ + l * 3 * DM, DM};
      gemm128<true, true>(tid, smem, H, DM, GFF + l * 3 * DM + row_mod(m0) * DM, WT_PQ + (size_t)l * DM * DM, DM, DM, m0, nt * 128, epi);
    }
    GRID_SYNC();
    FOR_VB(nact * 8 / 2) d_peer_topk(vb, TID(), smem, QP, peer_sub_keys + (size_t)l * 2 * 8 * 128 * 64, EIDX, GATE);
    GRID_SYNC();
    FOR_VB(nact) d_peer_gather(vb, TID(), smem, GFF + l * 3 * DM, EIDX, GATE, peer_u + (size_t)l * 16384 * DM, peer_v + (size_t)l * 16384 * DM, mod, H);
    GRID_SYNC();
  }
  FOR_VB(cdivd((size_t)NL * 64, 256)) d_final(vb, TID(), smem, H, final_norm_g, out);
}
}

extern "C" void kernel_launch(void* const* d_in, const int* in_sizes, int n_in, void* d_out, int out_size, void* d_ws,
                              size_t ws_size, hipStream_t stream) {
  Params p{};
  for (int i = 0; i < 38; ++i) p.in[i] = (const float*)d_in[i];
  p.out = (float*)d_out; p.ws = (char*)d_ws;
  if ((size_t)522000000 > ws_size) return;
  static int grid_blocks = 0;
  if (!grid_blocks) {
    int dev = 0, cus = 0, per_cu = 0;
    (void)hipGetDevice(&dev);
    (void)hipDeviceGetAttribute(&cus, hipDeviceAttributeMultiprocessorCount, dev);
#ifdef EMU
    per_cu = 1;
#else
    (void)hipFuncSetAttribute((const void*)mega, hipFuncAttributeMaxDynamicSharedMemorySize, LDS_BYTES);
    (void)hipOccupancyMaxActiveBlocksPerMultiprocessor(&per_cu, (const void*)mega, 256, LDS_BYTES);
#endif
    if (per_cu > 1) per_cu = 1;
    grid_blocks = cus * per_cu;
  }
  if (grid_blocks <= 0) return;
#ifdef EMU
  emu_launch(dim3(grid_blocks), dim3(256), true, [=]() { mega(p); });
#else
  (void)hipMemsetAsync(d_ws, 0, 16384, stream);
  void* args[] = {&p};
  hipError_t e = hipLaunchCooperativeKernel((void*)mega, dim3(grid_blocks), dim3(256), args, LDS_BYTES, stream);
  if (e != hipSuccess) fprintf(stderr, "cooperative launch failed: %s (grid %d)\n", hipGetErrorString(e), grid_blocks);
#endif
}
```

```cpp
#ifndef EMU
#include <hip/hip_runtime.h>
#include <hip/hip_cooperative_groups.h>
#include <cstdio>
#endif
#include <stdint.h>
#include <stddef.h>

#ifndef SEQ_
#define SEQ_ 8192
#endif
#ifndef CTX_
#define CTX_ 256
#endif

#ifdef EMU
#define GRID_SYNC() emu_grid_sync()
#else
#define XB_TMO      128
#define XB_XCNT(j)  (256  + 64 * (j))
#define XB_XSUB(j)  (1280 + 64 * (j))
#define XB_XGEN(j)  (2304 + 64 * (j))
#define XB_TOP      3328
#define XB_TOPGEN   3392
#define XCD_BAR_WORDS 3456
#define XB_SPIN_CAP (1u << 24)
__device__ __forceinline__ unsigned xb_ld(unsigned* p)              { return __hip_atomic_load(p, __ATOMIC_RELAXED, __HIP_MEMORY_SCOPE_AGENT); }
__device__ __forceinline__ unsigned xb_add(unsigned* p, unsigned v) { return __hip_atomic_fetch_add(p, v, __ATOMIC_RELAXED, __HIP_MEMORY_SCOPE_AGENT); }
#define XB_SPIN(cond, bar) do { unsigned _sp = 0; while (cond) { __builtin_amdgcn_s_sleep(1); \
    if ((++_sp & 255u) == 0u) { if (xb_ld(&(bar)[XB_TMO])) break; if (_sp > XB_SPIN_CAP) { atomicAdd(&(bar)[XB_TMO], 1u); break; } } } } while (0)
struct XBar { unsigned* bar; unsigned x; volatile unsigned* st; };
__device__ __forceinline__ XBar xbar_init(unsigned* bar, volatile unsigned* st) {
  XBar b; b.bar = bar; b.x = (unsigned)__builtin_amdgcn_s_getreg((3 << 11) | 20) & 0xFu; b.st = st;
  if (threadIdx.x == 0) {
    (void)xb_add(&bar[XB_XCNT(b.x)], 1u);
    const unsigned G = gridDim.x;
    unsigned sum, cnt, mine, sp = 0u;
    for (;;) {
      sum = 0u; cnt = 0u; mine = 0u;
#pragma unroll
      for (unsigned j = 0; j < 16; ++j) { const unsigned c = xb_ld(&bar[XB_XCNT(j)]); sum += c; cnt += (c > 0u) ? 1u : 0u; mine = (j == b.x) ? c : mine; }
      if (sum == G) break;
      __builtin_amdgcn_s_sleep(1);
      if ((++sp & 255u) == 0u) { if (xb_ld(&bar[XB_TMO])) break; if (sp > XB_SPIN_CAP) { atomicAdd(&bar[XB_TMO], 1u); break; } }
    }
    st[0] = mine > 0u ? mine : 1u; st[1] = cnt > 0u ? cnt : 1u;
  }
  __syncthreads();
  return b;
}
__device__ __forceinline__ void xbar_sync(const XBar& b) {
  asm volatile("s_waitcnt vmcnt(0)" ::: "memory");
  __syncthreads();
  if (threadIdx.x == 0) {
    unsigned* bar = b.bar;
    __builtin_amdgcn_s_waitcnt(0);
    const unsigned nloc = b.st[0], nx = b.st[1];
    const unsigned old = xb_add(&bar[XB_XSUB(b.x)], 1u);
    const unsigned gen = old / nloc;
    if (old + 1u == (gen + 1u) * nloc) {
      __builtin_amdgcn_fence(__ATOMIC_RELEASE, "agent");
      asm volatile("s_waitcnt vmcnt(0)" ::: "memory");
      const unsigned og = xb_add(&bar[XB_TOP], 1u);
      const unsigned tg = og / nx;
      if (og + 1u == (tg + 1u) * nx) xb_add(&bar[XB_TOPGEN], 1u);
      else XB_SPIN(xb_ld(&bar[XB_TOPGEN]) == tg, bar);
      __builtin_amdgcn_fence(__ATOMIC_ACQUIRE, "agent");
      xb_add(&bar[XB_XGEN(b.x)], 1u);
      asm volatile("s_waitcnt vmcnt(0)" ::: "memory");
    } else {
      XB_SPIN(xb_ld(&bar[XB_XGEN(b.x)]) == gen, bar);
      __builtin_amdgcn_fence(__ATOMIC_ACQUIRE, "agent");
      asm volatile("s_waitcnt vmcnt(0)" ::: "memory");
    }
  }
  __syncthreads();
}
#define GRID_SYNC() xbar_sync(xbar)
#endif

namespace {
constexpr int DM = 1024, NB = 2, SEQ = SEQ_, CTX = CTX_, GRIDW = 64;
constexpr int NL = NB * SEQ, NC = NB * CTX, NT = NL + NC;
constexpr int DIN = 2504, NMOD = 6;
constexpr int O_SSD = 0, O_GLA = 1032, O_MLA = 1832, O_S5 = 2248;
constexpr float EPS = 1e-6f;

__device__ __forceinline__ float siluf(float x) { return x / (1.f + expf(-x)); }
__device__ __forceinline__ float sigmoidf_(float x) { return 1.f / (1.f + expf(-x)); }
__device__ __forceinline__ float softplusf(float x) { return x > 20.f ? x : log1pf(expf(x)); }
__device__ __forceinline__ float logsigmoidf(float x) { return -softplusf(-x); }
__device__ __forceinline__ float geluf(float x) { return 0.5f * x * (1.f + erff(x * 0.70710678118654752f)); }
__device__ __forceinline__ float wave_sum(float v) {
#pragma unroll
  for (int m = 32; m >= 1; m >>= 1) v += __shfl_xor(v, m);
  return v;
}
__device__ __forceinline__ int row_mod(int r) { return r < NL ? r / SEQ : 2; }


typedef short s8v __attribute__((ext_vector_type(8)));
typedef float f16v __attribute__((ext_vector_type(16)));
typedef float f4v __attribute__((ext_vector_type(4)));
typedef unsigned short bf16_t;
#ifdef EMU
static inline unsigned __float_as_uint(float f) { unsigned u; memcpy(&u, &f, 4); return u; }
static inline float __uint_as_float(unsigned u) { float f; memcpy(&f, &u, 4); return f; }
#endif
__device__ __forceinline__ bf16_t f2bf(float f) { unsigned u = __float_as_uint(f); u += 0x7fffu + ((u >> 16) & 1u); return (bf16_t)(u >> 16); }
__device__ __forceinline__ unsigned pack_bf2(float a, float b) { return (unsigned)f2bf(a) | ((unsigned)f2bf(b) << 16); }
__device__ __forceinline__ float bf2f(bf16_t b) { return __uint_as_float((unsigned)b << 16); }
__device__ __forceinline__ float bflo(unsigned u) { return __uint_as_float(u << 16); }
__device__ __forceinline__ float bfhi(unsigned u) { return __uint_as_float(u & 0xffff0000u); }

constexpr int PLD = 2560;
struct PRow { const bf16_t* p; __device__ __forceinline__ float operator[](int i) const { return bf2f(p[i]); } };
__device__ __forceinline__ void d_transpose_w(int vb, int tid, char* smem, const float* W, bf16_t* Wt, int K, int N, int Npad) {
  float (*tile)[65] = (float (*)[65])smem;
  int nkt = K / 64; int kt = vb % nkt, nt = vb / nkt;
#pragma unroll 4
  for (int i = 0; i < 16; ++i) {
    int kk = i * 4 + (tid >> 6), nn = tid & 63; int n = nt * 64 + nn;
    tile[kk][nn] = (n < N) ? W[(size_t)(kt * 64 + kk) * N + n] : 0.f;
  }
  __syncthreads();
#pragma unroll 4
  for (int i = 0; i < 16; ++i) {
    int nn = i * 4 + (tid >> 6), kk = tid & 63;
    Wt[(size_t)(nt * 64 + nn) * K + kt * 64 + kk] = f2bf(tile[kk][nn]);
  }
  __syncthreads();
}
__device__ __forceinline__ void d_shiftvec(int vb, int tid, const float* W, int N, const float* mod, int ishift, float* T, int ldt) {
  int idx = vb * 256 + tid; if (idx >= 3 * N) return;
  int mb = idx / N, n = idx % N;
  const float* sh = mod + mb * NMOD * DM + ishift * DM;
  float s = 0.f;
  for (int k = 0; k < DM; ++k) s += sh[k] * W[(size_t)k * N + n];
  T[mb * ldt + n] = s;
}
__device__ __forceinline__ void d_gainvec(int vb, int tid, const float* g, const float* mod, int iscale, float* G) {
  int idx = vb * 256 + tid; if (idx >= 3 * DM) return;
  int mb = idx / DM, k = idx % DM;
  G[idx] = g[k] * (1.f + mod[mb * NMOD * DM + iscale * DM + k]);
}

template <bool AF32, bool SUMSQ, class Epi>
__device__ __forceinline__ void gemm128(int tid, char* smem, const void* Aptr, int lda, const float* gain, const bf16_t* Wt, int ldw, int K,
                                        int m0, int n0, Epi epi) {
  const int lane = tid & 63, w = tid >> 6, wm = w >> 1, wn = w & 1;
  f16v acc[2][2];
#pragma unroll
  for (int i = 0; i < 2; ++i)
#pragma unroll
    for (int j = 0; j < 2; ++j)
#pragma unroll
      for (int r = 0; r < 16; ++r) acc[i][j][r] = 0.f;
  float ss[8];
#pragma unroll
  for (int i = 0; i < 8; ++i) ss[i] = 0.f;
  float4 raf[8]; uint4 rab[4]; uint4 rb[4];
  const int nk = K / 64;
  auto load_tile = [&](int kt) {
    const int k0 = kt * 64;
    if (AF32) {
      const float* A = (const float*)Aptr;
      const int c4 = tid & 15;
#pragma unroll
      for (int i = 0; i < 8; ++i) {
        int row = (tid >> 4) + 16 * i;
        raf[i] = *(const float4*)(A + (size_t)(m0 + row) * lda + k0 + c4 * 4);
      }
    } else {
      const bf16_t* A = (const bf16_t*)Aptr;
      const int c = tid & 7;
#pragma unroll
      for (int i = 0; i < 4; ++i) {
        int row = (tid >> 3) + 32 * i;
        rab[i] = *(const uint4*)(A + (size_t)(m0 + row) * lda + k0 + c * 8);
      }
    }
    {
      const int c = tid & 7;
#pragma unroll
      for (int i = 0; i < 4; ++i) {
        int row = (tid >> 3) + 32 * i;
        rb[i] = *(const uint4*)(Wt + (size_t)(n0 + row) * ldw + k0 + c * 8);
      }
    }
  };
  auto store_tile = [&](int kt, int buf) {
    char* bA = smem + buf * 16384; char* bB = smem + 32768 + buf * 16384;
    if (AF32) {
      const int c4 = tid & 15;
      float4 g = make_float4(1.f, 1.f, 1.f, 1.f);
      if (gain) g = *(const float4*)(gain + kt * 64 + c4 * 4);
#pragma unroll
      for (int i = 0; i < 8; ++i) {
        int row = (tid >> 4) + 16 * i;
        float4 v = raf[i];
        if (SUMSQ) ss[i] += v.x * v.x + v.y * v.y + v.z * v.z + v.w * v.w;
        uint2 pk = make_uint2(pack_bf2(v.x * g.x, v.y * g.y), pack_bf2(v.z * g.z, v.w * g.w));
        *(uint2*)(bA + row * 128 + ((((c4 >> 1) ^ ((row >> 1) & 7))) << 4) + (c4 & 1) * 8) = pk;
      }
    } else {
      const int c = tid & 7;
#pragma unroll
      for (int i = 0; i < 4; ++i) {
        int row = (tid >> 3) + 32 * i;
        if (SUMSQ) {
          const uint4 q = rab[i];
          const float e0 = bflo(q.x), e1 = bfhi(q.x), e2 = bflo(q.y), e3 = bfhi(q.y), e4 = bflo(q.z), e5 = bfhi(q.z), e6 = bflo(q.w), e7 = bfhi(q.w);
          ss[i] += e0 * e0 + e1 * e1 + e2 * e2 + e3 * e3 + e4 * e4 + e5 * e5 + e6 * e6 + e7 * e7;
        }
        *(uint4*)(bA + row * 128 + ((c ^ ((row >> 1) & 7)) << 4)) = rab[i];
      }
    }
    {
      const int c = tid & 7;
#pragma unroll
      for (int i = 0; i < 4; ++i) {
        int row = (tid >> 3) + 32 * i;
        *(uint4*)(bB + row * 128 + ((c ^ ((row >> 1) & 7)) << 4)) = rb[i];
      }
    }
  };
  load_tile(0);
  store_tile(0, 0);
  __syncthreads();
  for (int kt = 0; kt < nk; ++kt) {
    const int buf = kt & 1;
    if (kt + 1 < nk) load_tile(kt + 1);
    const char* bA = smem + buf * 16384; const char* bB = smem + 32768 + buf * 16384;
#pragma unroll
    for (int ks = 0; ks < 4; ++ks) {
      s8v af[2], bfr[2];
      const int c = ks * 2 + (lane >> 5);
#pragma unroll
      for (int t = 0; t < 2; ++t) {
        int ra = wm * 64 + t * 32 + (lane & 31);
        af[t] = *(const s8v*)(bA + ra * 128 + ((c ^ ((ra >> 1) & 7)) << 4));
        int rbb = wn * 64 + t * 32 + (lane & 31);
        bfr[t] = *(const s8v*)(bB + rbb * 128 + ((c ^ ((rbb >> 1) & 7)) << 4));
      }
#pragma unroll
      for (int i = 0; i < 2; ++i)
#pragma unroll
        for (int j = 0; j < 2; ++j) acc[i][j] = __builtin_amdgcn_mfma_f32_32x32x16_bf16(af[i], bfr[j], acc[i][j], 0, 0, 0);
    }
    if (kt + 1 < nk) store_tile(kt + 1, buf ^ 1);
    __syncthreads();
  }
  float* rs_lds = (float*)smem;
  if (SUMSQ) {
    if (AF32) {
#pragma unroll
      for (int i = 0; i < 8; ++i) {
        float s = ss[i];
        s += __shfl_xor(s, 1); s += __shfl_xor(s, 2); s += __shfl_xor(s, 4); s += __shfl_xor(s, 8);
        if ((tid & 15) == 0) rs_lds[(tid >> 4) + 16 * i] = rsqrtf(s / (float)K + EPS);
      }
    } else {
#pragma unroll
      for (int i = 0; i < 4; ++i) {
        float s = ss[i];
        s += __shfl_xor(s, 1); s += __shfl_xor(s, 2); s += __shfl_xor(s, 4);
        if ((tid & 7) == 0) rs_lds[(tid >> 3) + 32 * i] = rsqrtf(s / (float)K + EPS);
      }
    }
    __syncthreads();
  }
#pragma unroll
  for (int i = 0; i < 2; ++i)
#pragma unroll
    for (int j = 0; j < 2; ++j)
#pragma unroll
      for (int r = 0; r < 16; ++r) {
        int rl = wm * 64 + i * 32 + (r & 3) + 8 * (r >> 2) + 4 * (lane >> 5);
        int col = n0 + wn * 64 + j * 32 + (lane & 31);
        epi(m0 + rl, col, acc[i][j][r], SUMSQ ? rs_lds[rl] : 1.f);
      }
  __syncthreads();
}
struct EpiStoreF32 {
  float* C; int ldc; int N; const float* bias; int ldb;
  __device__ __forceinline__ void operator()(int row, int col, float v, float rs) const {
    if (col < N) C[(size_t)row * ldc + col] = rs * v + (bias ? bias[row_mod(row) * ldb + col] : 0.f);
  }
};
struct EpiStoreBf16 {
  bf16_t* C; int ldc; const float* bias; int ldb;
  __device__ __forceinline__ void operator()(int row, int col, float v, float rs) const {
    C[(size_t)row * ldc + col] = f2bf(rs * v + (bias ? bias[row_mod(row) * ldb + col] : 0.f));
  }
};
struct EpiResid {
  float* H; const float* mod; int imod;
  __device__ __forceinline__ void operator()(int row, int col, float v, float) const {
    H[(size_t)row * DM + col] += mod[row_mod(row) * NMOD * DM + imod * DM + col] * v;
  }
};

__device__ __forceinline__ void d_mod(int vb, int tidp, char* smem, const float* c, const float* c_ctx, const float* ada_w, const float* ada_b, float* mod) {
  int idx = vb * 256 + tidp;
  if (idx >= 2 * 3 * NMOD * DM) return;
  int j = idx % (NMOD * DM); int m = (idx / (NMOD * DM)) % 3; int l = idx / (3 * NMOD * DM);
  const float* cv = m < 2 ? c + m * DM : c_ctx;
  const float* w = ada_w + (size_t)l * DM * NMOD * DM;
  float s = 0.f;
  for (int k = 0; k < DM; ++k) s += siluf(cv[k]) * w[(size_t)k * NMOD * DM + j];
  mod[idx] = s + ada_b[l * NMOD * DM + j];
}
__device__ __forceinline__ void d_copy_h(int vb, int tidp, char* smem, const float* x, const float* ctx, float* H) {
  size_t i = (size_t)vb * 256 + tidp;
  if (i >= (size_t)NT * DM) return;
  H[i] = i < (size_t)NL * DM ? x[i] : ctx[i - (size_t)NL * DM];
}
constexpr int NCH128 = (CTX + SEQ) / 128, NCC128 = CTX / 128;
__device__ __forceinline__ int chunk128_row0(int b, int c) { return c < NCC128 ? NL + b * CTX + c * 128 : b * SEQ + (c - NCC128) * 128; }
__device__ __forceinline__ int chain128(int dir, int k) { return dir == 0 ? k : (k < NCC128 ? NCC128 - 1 - k : NCH128 - 1 - (k - NCC128)); }
constexpr int SSD_LDT = 136;
__device__ __forceinline__ void ssd_A(int item, int tid, char* smem, const bf16_t* P, const float* conv_w, const float* conv_b, const float* a_log,
                                      const float* dt_bias, bf16_t* XBC, bf16_t* XT, float* DA, float* ST) {
  const int h = item & 3, c = (item >> 2) % NCH128, b = (item >> 2) / NCH128, g = h >> 1;
  const int w = tid >> 6, lane = tid & 63;
  const int row0 = chunk128_row0(b, c);
  const int t0 = (c < NCC128) ? c * 128 : (c - NCC128) * 128, len = (c < NCC128) ? CTX : SEQ;
  bf16_t* xT = (bf16_t*)smem;
  bf16_t* BT = (bf16_t*)(smem + 64 * SSD_LDT * 2);
  float* acs = (float*)(smem + 192 * SSD_LDT * 2);
  float* wls = acs + 256;
  const int nsets = (h & 1) ? 3 : 5;
  for (int s = 0; s < nsets; ++s) {
    const int col = (s == 0) ? h * 64 + lane : (s < 3 ? 256 + g * 128 + (s - 1) * 64 + lane : 512 + g * 128 + (s - 3) * 64 + lane);
    float cw[5];
#pragma unroll
    for (int k = 0; k < 5; ++k) cw[k] = conv_w[k * 768 + col];
    const float cb = conv_b[col];
    float win[5];
#pragma unroll
    for (int k = 0; k < 4; ++k) { const int tt = t0 + w * 32 - 2 + k; win[k + 1] = (tt >= 0 && tt < len) ? bf2f(P[(size_t)(row0 + w * 32 - 2 + k) * PLD + O_SSD + 256 + col]) : 0.f; }
    float prev = 0.f;
    for (int j = 0; j < 32; ++j) {
      const int tl = w * 32 + j;
#pragma unroll
      for (int k = 0; k < 4; ++k) win[k] = win[k + 1];
      { const int tt = t0 + tl + 2; win[4] = (tt < len) ? bf2f(P[(size_t)(row0 + tl + 2) * PLD + O_SSD + 256 + col]) : 0.f; }
      float y = cb;
#pragma unroll
      for (int k = 0; k < 5; ++k) y += cw[k] * win[k];
      y = siluf(y);
      XBC[(size_t)(row0 + tl) * 768 + col] = f2bf(y);
      if (s < 3) {
        if (j & 1) {
          bf16_t* dst = (s == 0) ? xT + lane * SSD_LDT : BT + ((s - 1) * 64 + lane) * SSD_LDT;
          *(unsigned*)(dst + tl - 1) = pack_bf2(prev, y);
        }
        prev = y;
      }
    }
  }
  if (w < 2) {
    const int dir = w;
    const float bias = dt_bias[dir * 4 + h], ah = -expf(a_log[dir * 4 + h]);
    const float d0 = softplusf(bf2f(P[(size_t)(row0 + 2 * lane) * PLD + O_SSD + 1024 + dir * 4 + h]) + bias);
    const float d1 = softplusf(bf2f(P[(size_t)(row0 + 2 * lane + 1) * PLD + O_SSD + 1024 + dir * 4 + h]) + bias);
    const float s0 = d0 * ah, s1 = d1 * ah;
    float pre = s0 + s1;
#pragma unroll
    for (int o = 1; o < 64; o <<= 1) { const float v = __shfl_up(pre, o); if (lane >= o) pre += v; }
    const float tot = __shfl(pre, 63);
    float a0, a1;
    if (dir == 0) { a0 = pre - s1; a1 = pre; } else { const float suf = tot - pre + s0 + s1; a0 = suf; a1 = suf - s0; }
    float* da = DA + (size_t)((((b * NCH128 + c) * 2 + dir) * 4 + h) * 2) * 128;
    da[2 * lane] = a0; da[2 * lane + 1] = a1; da[128 + 2 * lane] = d0; da[128 + 2 * lane + 1] = d1;
    wls[dir * 128 + 2 * lane] = expf(tot - a0) * d0; wls[dir * 128 + 2 * lane + 1] = expf(tot - a1) * d1;
  }
  __syncthreads();
  {
    bf16_t* xt = XT + (size_t)((b * NCH128 + c) * 4 + h) * 64 * 128;
#pragma unroll
    for (int i = 0; i < 4; ++i) {
      const int id = tid + 256 * i, p = id >> 4, ch = id & 15;
      *(uint4*)(xt + p * 128 + ch * 8) = *(const uint4*)(xT + p * SSD_LDT + ch * 8);
    }
  }
  {
    const int dir = w >> 1, pt = w & 1;
    f16v acc[4];
#pragma unroll
    for (int i = 0; i < 4; ++i)
#pragma unroll
      for (int r = 0; r < 16; ++r) acc[i][r] = 0.f;
#pragma unroll 2
    for (int ks = 0; ks < 8; ++ks) {
      const int j0 = ks * 16 + 8 * (lane >> 5);
      const uint4 xa = *(const uint4*)(xT + (pt * 32 + (lane & 31)) * SSD_LDT + j0);
      const float4 w0 = *(const float4*)(wls + dir * 128 + j0), w1 = *(const float4*)(wls + dir * 128 + j0 + 4);
      uint4 xs;
      xs.x = pack_bf2(bflo(xa.x) * w0.x, bfhi(xa.x) * w0.y); xs.y = pack_bf2(bflo(xa.y) * w0.z, bfhi(xa.y) * w0.w);
      xs.z = pack_bf2(bflo(xa.z) * w1.x, bfhi(xa.z) * w1.y); xs.w = pack_bf2(bflo(xa.w) * w1.z, bfhi(xa.w) * w1.w);
      s8v af; __builtin_memcpy(&af, &xs, 16);
#pragma unroll
      for (int nt = 0; nt < 4; ++nt) {
        const s8v bfr = *(const s8v*)(BT + (nt * 32 + (lane & 31)) * SSD_LDT + j0);
        acc[nt] = __builtin_amdgcn_mfma_f32_32x32x16_bf16(af, bfr, acc[nt], 0, 0, 0);
      }
    }
    float* st = ST + ((size_t)((b * 2 + dir) * 4 + h) * NCH128 + c) * 8192;
#pragma unroll
    for (int nt = 0; nt < 4; ++nt)
#pragma unroll
      for (int r = 0; r < 16; ++r) {
        const int p = pt * 32 + (r & 3) + 8 * (r >> 2) + 4 * (lane >> 5);
        st[p * 128 + nt * 32 + (lane & 31)] = acc[nt][r];
      }
  }
  __syncthreads();
}
__device__ __forceinline__ void ssd_B(int vb, int tid, const float* ST, const float* DA, bf16_t* HIN) {
  const int idx = vb * 256 + tid; if (idx >= NB * 2 * 4 * 8192) return;
  const int e = idx & 8191, bdh = idx >> 13, dir = (bdh >> 2) & 1, h = bdh & 3, b = bdh >> 3;
  float run = 0.f;
  for (int k = 0; k < NCH128; ++k) {
    const int c = chain128(dir, k);
    const size_t sidx = (size_t)bdh * NCH128 + c;
    HIN[sidx * 8192 + e] = f2bf(run);
    const float dec = expf(DA[(size_t)((((b * NCH128 + c) * 2 + dir) * 4 + h) * 2) * 128 + (dir ? 0 : 127)]);
    run = dec * run + ST[sidx * 8192 + e];
  }
}
__device__ __forceinline__ void ssd_C(int item, int tid, char* smem, const bf16_t* P, const bf16_t* XBC, const bf16_t* XT, const float* DA,
                                      const bf16_t* HIN, const float* d_skip, const float* norm_g, bf16_t* CAT) {
  const int ib = item & 3, c = (item >> 2) % NCH128, b = (item >> 2) / NCH128;
  const int h = tid >> 6, lane = tid & 63, g = h >> 1, hl = lane >> 5, li = lane & 31;
  const int row0 = chunk128_row0(b, c);
  const int il = ib * 32 + li;
  float* red = (float*)smem;
  s8v cf[8];
#pragma unroll
  for (int ks = 0; ks < 8; ++ks) cf[ks] = *(const s8v*)(XBC + (size_t)(row0 + il) * 768 + 512 + g * 128 + ks * 16 + 8 * hl);
  f16v acc[2];
#pragma unroll
  for (int i = 0; i < 2; ++i)
#pragma unroll
    for (int r = 0; r < 16; ++r) acc[i][r] = 0.f;
  float aci[2];
#pragma unroll
  for (int dir = 0; dir < 2; ++dir) {
    const float* da = DA + (size_t)((((b * NCH128 + c) * 2 + dir) * 4 + h) * 2) * 128;
    aci[dir] = da[il];
    const bf16_t* hin = HIN + ((size_t)((b * 2 + dir) * 4 + h) * NCH128 + c) * 8192;
    f16v tmp[2];
#pragma unroll
    for (int i = 0; i < 2; ++i)
#pragma unroll
      for (int r = 0; r < 16; ++r) tmp[i][r] = 0.f;
#pragma unroll
    for (int ks = 0; ks < 8; ++ks)
#pragma unroll
      for (int pt = 0; pt < 2; ++pt) {
        const s8v af = *(const s8v*)(hin + (pt * 32 + li) * 128 + ks * 16 + 8 * hl);
        tmp[pt] = __builtin_amdgcn_mfma_f32_32x32x16_bf16(af, cf[ks], tmp[pt], 0, 0, 0);
      }
    const float ea = expf(aci[dir]);
#pragma unroll
    for (int pt = 0; pt < 2; ++pt)
#pragma unroll
      for (int r = 0; r < 16; ++r) acc[pt][r] += tmp[pt][r] * ea;
  }
  const bf16_t* xt = XT + (size_t)((b * NCH128 + c) * 4 + h) * 64 * 128;
  for (int jb = 0; jb < 4; ++jb) {
    f16v X;
#pragma unroll
    for (int r = 0; r < 16; ++r) X[r] = 0.f;
#pragma unroll
    for (int ks = 0; ks < 8; ++ks) {
      const s8v af = *(const s8v*)(XBC + (size_t)(row0 + jb * 32 + li) * 768 + 256 + g * 128 + ks * 16 + 8 * hl);
      X = __builtin_amdgcn_mfma_f32_32x32x16_bf16(af, cf[ks], X, 0, 0, 0);
    }
#pragma unroll
    for (int dir = 0; dir < 2; ++dir) {
      if (dir == 0 ? (jb > ib) : (jb < ib)) continue;
      const float* da = DA + (size_t)((((b * NCH128 + c) * 2 + dir) * 4 + h) * 2) * 128;
      float m[16];
#pragma unroll
      for (int q = 0; q < 4; ++q) {
        const int j0 = jb * 32 + 8 * q + 4 * hl;
        const float4 aj = *(const float4*)(da + j0), dj = *(const float4*)(da + 128 + j0);
        const float ajv[4] = {aj.x, aj.y, aj.z, aj.w}, djv[4] = {dj.x, dj.y, dj.z, dj.w};
#pragma unroll
        for (int e = 0; e < 4; ++e) {
          const int j = j0 + e;
          const bool ok = (dir == 0) ? (j <= il) : (j >= il);
          const float ex = expf(fminf(aci[dir] - ajv[e], 0.f));
          m[q * 4 + e] = ok ? X[q * 4 + e] * ex * djv[e] : 0.f;
        }
      }
#pragma unroll
      for (int s = 0; s < 2; ++s) {
        uint4 mb;
        mb.x = pack_bf2(m[8 * s + 0], m[8 * s + 1]); mb.y = pack_bf2(m[8 * s + 2], m[8 * s + 3]);
        mb.z = pack_bf2(m[8 * s + 4], m[8 * s + 5]); mb.w = pack_bf2(m[8 * s + 6], m[8 * s + 7]);
        s8v bfr; __builtin_memcpy(&bfr, &mb, 16);
#pragma unroll
        for (int pt = 0; pt < 2; ++pt) {
          const bf16_t* xr = xt + (pt * 32 + li) * 128 + jb * 32 + 16 * s + 4 * hl;
          const uint2 lo = *(const uint2*)xr, hi = *(const uint2*)(xr + 8);
          uint4 xa; xa.x = lo.x; xa.y = lo.y; xa.z = hi.x; xa.w = hi.y;
          s8v af; __builtin_memcpy(&af, &xa, 16);
          acc[pt] = __builtin_amdgcn_mfma_f32_32x32x16_bf16(af, bfr, acc[pt], 0, 0, 0);
        }
      }
    }
  }
  const float dsk = d_skip[h];
  float ssq = 0.f;
  const size_t row = (size_t)(row0 + il);
#pragma unroll
  for (int pt = 0; pt < 2; ++pt)
#pragma unroll
    for (int q = 0; q < 4; ++q) {
      const int p0 = pt * 32 + 8 * q + 4 * hl;
      const uint2 xs = *(const uint2*)(XBC + row * 768 + h * 64 + p0);
      const uint2 zz = *(const uint2*)(P + row * PLD + O_SSD + h * 64 + p0);
      const float xv[4] = {bflo(xs.x), bfhi(xs.x), bflo(xs.y), bfhi(xs.y)}, zv[4] = {bflo(zz.x), bfhi(zz.x), bflo(zz.y), bfhi(zz.y)};
#pragma unroll
      for (int e = 0; e < 4; ++e) {
        const float y = (acc[pt][q * 4 + e] + dsk * xv[e]) * siluf(zv[e]);
        acc[pt][q * 4 + e] = y; ssq += y * y;
      }
    }
  ssq += __shfl_xor(ssq, 32);
  if (lane < 32) red[h * 32 + li] = ssq;
  __syncthreads();
  const float tot = red[li] + red[32 + li] + red[64 + li] + red[96 + li];
  const float rs = rsqrtf(tot * (1.f / 256.f) + EPS);
#pragma unroll
  for (int pt = 0; pt < 2; ++pt)
#pragma unroll
    for (int q = 0; q < 4; ++q) {
      const int p0 = pt * 32 + 8 * q + 4 * hl;
      const float4 ng = *(const float4*)(norm_g + h * 64 + p0);
      uint2 o; o.x = pack_bf2(acc[pt][q * 4 + 0] * rs * ng.x, acc[pt][q * 4 + 1] * rs * ng.y); o.y = pack_bf2(acc[pt][q * 4 + 2] * rs * ng.z, acc[pt][q * 4 + 3] * rs * ng.w);
      *(uint2*)(CAT + row * DM + h * 64 + p0) = o;
    }
  __syncthreads();
}
constexpr int NCH64 = (CTX + SEQ) / 64, NCC64 = CTX / 64;
__device__ __forceinline__ int chunk64_row0(int b, int c) { return c < NCC64 ? NL + b * CTX + c * 64 : b * SEQ + (c - NCC64) * 64; }
__device__ __forceinline__ int chain64(int dir, int k) { return dir == 0 ? k : (k < NCC64 ? NCC64 - 1 - k : NCH64 - 1 - (k - NCC64)); }
__device__ __forceinline__ void gla_A(int item, int tid, char* smem, const bf16_t* P, const float* gate_w, const float* gate_b, float* ST, float* GP) {
  const int dir = item & 1, c = (item >> 1) % NCH64, b = (item >> 1) / NCH64;
  const int h = tid >> 6, lane = tid & 63, d = lane & 31, tp = lane >> 5;
  const int row0 = chunk64_row0(b, c);
  float* kbuf = (float*)(smem + h * 16384); float* gbuf = kbuf + 64 * 32;
  float gw[16];
#pragma unroll
  for (int r = 0; r < 16; ++r) gw[r] = gate_w[(dir * 16 + r) * 128 + h * 32 + d];
  const float gb = gate_b[dir * 128 + h * 32 + d];
  float lsum = 0.f;
  for (int tt = 0; tt < 32; ++tt) {
    const int t = 2 * tt + tp;
    const bf16_t* pr = P + (size_t)(row0 + t) * PLD + O_GLA;
    float z = gb;
#pragma unroll
    for (int r = 0; r < 16; ++r) z += bf2f(pr[768 + dir * 16 + r]) * gw[r];
    const float lg = logsigmoidf(z) * (1.f / 16.f);
    lsum += lg;
    kbuf[t * 32 + d] = bf2f(pr[128 + h * 32 + d]); gbuf[t * 32 + d] = expf(lg);
  }
  lsum += __shfl_xor(lsum, 32);
  const size_t sidx = (size_t)((b * 2 + dir) * 4 + h) * NCH64 + c;
  if (lane < 32) GP[sidx * 32 + d] = expf(lsum);
  __syncthreads();
  float S[32];
#pragma unroll
  for (int i = 0; i < 32; ++i) S[i] = 0.f;
#pragma unroll 4
  for (int s = 0; s < 64; ++s) {
    const int t = dir ? 63 - s : s;
    const float v = bf2f(P[(size_t)(row0 + t) * PLD + O_GLA + 256 + h * 64 + lane]);
    const float4* k4 = (const float4*)(kbuf + t * 32); const float4* g4 = (const float4*)(gbuf + t * 32);
#pragma unroll
    for (int i = 0; i < 8; ++i) {
      const float4 kk = k4[i], gg = g4[i];
      S[4 * i + 0] = gg.x * S[4 * i + 0] + kk.x * v; S[4 * i + 1] = gg.y * S[4 * i + 1] + kk.y * v;
      S[4 * i + 2] = gg.z * S[4 * i + 2] + kk.z * v; S[4 * i + 3] = gg.w * S[4 * i + 3] + kk.w * v;
    }
  }
#pragma unroll
  for (int i = 0; i < 32; ++i) ST[sidx * 2048 + i * 64 + lane] = S[i];
  __syncthreads();
}
__device__ __forceinline__ void gla_B(int vb, int tid, float* ST, const float* GP) {
  const int idx = vb * 256 + tid; if (idx >= NB * 2 * 4 * 2048) return;
  const int e = idx & 2047, bdh = idx >> 11, dk = e >> 6, dir = (bdh >> 2) & 1;
  float run = 0.f;
  for (int k = 0; k < NCH64; ++k) {
    const int c = chain64(dir, k);
    const size_t sidx = (size_t)bdh * NCH64 + c;
    const float loc = ST[sidx * 2048 + e];
    ST[sidx * 2048 + e] = run;
    run = GP[sidx * 32 + dk] * run + loc;
  }
}
__device__ __forceinline__ void gla_C(int item, int tid, char* smem, const bf16_t* P, const float* gate_w, const float* gate_b, const float* norm_g,
                                      const float* ST, bf16_t* CAT) {
  const int c = item % NCH64, b = item / NCH64;
  const int h = tid >> 6, lane = tid & 63, d = lane & 31, tp = lane >> 5;
  const int row0 = chunk64_row0(b, c);
  char* wb = smem + h * 16384;
  bf16_t* obuf = (bf16_t*)wb;
  float* gbuf = (float*)(wb + 8192);
  bf16_t* qbuf = (bf16_t*)(wb + 12288);
  bf16_t* kbuf = (bf16_t*)(wb + 14336);
  const float qs = 0.17677669529663687f;
  const float ng = norm_g[lane];
  for (int pass = 0; pass < 2; ++pass) {
    const int dir = 1 - pass;
    float gw[16];
#pragma unroll
    for (int r = 0; r < 16; ++r) gw[r] = gate_w[(dir * 16 + r) * 128 + h * 32 + d];
    const float gb = gate_b[dir * 128 + h * 32 + d];
    const size_t sidx = (size_t)((b * 2 + dir) * 4 + h) * NCH64 + c;
    float S[32];
#pragma unroll
    for (int i = 0; i < 32; ++i) S[i] = ST[sidx * 2048 + i * 64 + lane];
    for (int half = 0; half < 2; ++half) {
      for (int ss = 0; ss < 16; ++ss) {
        const int s = 2 * ss + tp; const int st = half * 32 + s; const int t = dir ? 63 - st : st;
        const bf16_t* pr = P + (size_t)(row0 + t) * PLD + O_GLA;
        float z = gb;
#pragma unroll
        for (int r = 0; r < 16; ++r) z += bf2f(pr[768 + dir * 16 + r]) * gw[r];
        gbuf[s * 32 + d] = expf(logsigmoidf(z) * (1.f / 16.f));
        qbuf[s * 32 + d] = pr[h * 32 + d]; kbuf[s * 32 + d] = pr[128 + h * 32 + d];
      }
      __syncthreads();
#pragma unroll 2
      for (int s = 0; s < 32; ++s) {
        const int st = half * 32 + s; const int t = dir ? 63 - st : st;
        const bf16_t* pr = P + (size_t)(row0 + t) * PLD + O_GLA;
        const float v = bf2f(pr[256 + h * 64 + lane]);
        float o = 0.f;
        const float4* g4 = (const float4*)(gbuf + s * 32);
        const uint4* q4 = (const uint4*)(qbuf + s * 32); const uint4* k4 = (const uint4*)(kbuf + s * 32);
#pragma unroll
        for (int i = 0; i < 4; ++i) {
          const uint4 qq = q4[i], kk = k4[i]; const float4 ga = g4[2 * i], gb4 = g4[2 * i + 1];
          float* Sp = S + 8 * i;
          Sp[0] = ga.x * Sp[0] + bflo(kk.x) * v;  o += bflo(qq.x) * Sp[0];
          Sp[1] = ga.y * Sp[1] + bfhi(kk.x) * v;  o += bfhi(qq.x) * Sp[1];
          Sp[2] = ga.z * Sp[2] + bflo(kk.y) * v;  o += bflo(qq.y) * Sp[2];
          Sp[3] = ga.w * Sp[3] + bfhi(kk.y) * v;  o += bfhi(qq.y) * Sp[3];
          Sp[4] = gb4.x * Sp[4] + bflo(kk.z) * v; o += bflo(qq.z) * Sp[4];
          Sp[5] = gb4.y * Sp[5] + bfhi(kk.z) * v; o += bfhi(qq.z) * Sp[5];
          Sp[6] = gb4.z * Sp[6] + bflo(kk.w) * v; o += bflo(qq.w) * Sp[6];
          Sp[7] = gb4.w * Sp[7] + bfhi(kk.w) * v; o += bfhi(qq.w) * Sp[7];
        }
        o *= qs;
        if (pass == 0) obuf[t * 64 + lane] = f2bf(o);
        else {
          o += bf2f(obuf[t * 64 + lane]);
          const float ssq = wave_sum(o * o);
          const float rs = rsqrtf(ssq * (1.f / 64.f) + EPS);
          { const float ov = o * rs * ng * siluf(bf2f(pr[512 + h * 64 + lane])); const float onb = __shfl_xor(ov, 1);
            if (!(lane & 1)) *(unsigned*)(CAT + (size_t)(row0 + t) * DM + 256 + h * 64 + lane) = pack_bf2(ov, onb); }
        }
      }
      __syncthreads();
    }
  }
}
constexpr int LK = SEQ + CTX;
constexpr float QSCALE = 0.14724447f;
__device__ __forceinline__ void row_bk(int row, int& b, int& kidx) {
  if (row < NL) { b = row / SEQ; kidx = row % SEQ; } else { b = (row - NL) / CTX; kidx = SEQ + (row - NL) % CTX; }
}
__device__ __forceinline__ void d_rope_tab(int vb, int tid, float2* ROPE) {
  const int idx = vb * 256 + tid; if (idx >= SEQ * 16) return;
  const int t = idx >> 4, i = idx & 15, f = i & 7;
  const float inv = powf(10000.f, -(float)(2 * f) / 16.f);
  const float ang = (i < 8 ? (float)(t / GRIDW) : (float)(t % GRIDW)) * inv;
  ROPE[idx] = make_float2(cosf(ang), sinf(ang));
}
__device__ __forceinline__ void d_transpose_wg(int vb, int tid, char* smem, const float* W, const float* g, bf16_t* Wt, int K, int N) {
  float (*tile)[65] = (float (*)[65])smem;
  int nkt = K / 64; int kt = vb % nkt, nt = vb / nkt;
#pragma unroll 4
  for (int i = 0; i < 16; ++i) {
    int kk = i * 4 + (tid >> 6), nn = tid & 63;
    tile[kk][nn] = W[(size_t)(kt * 64 + kk) * N + nt * 64 + nn] * g[kt * 64 + kk];
  }
  __syncthreads();
#pragma unroll 4
  for (int i = 0; i < 16; ++i) {
    int nn = i * 4 + (tid >> 6), kk = tid & 63;
    if (!(kk & 1)) *(unsigned*)(Wt + (size_t)(nt * 64 + nn) * K + kt * 64 + kk) = pack_bf2(tile[kk][nn], tile[kk + 1][nn]);
  }
  __syncthreads();
}
struct EpiMlaQ {
  bf16_t* Q; const float2* rope;
  __device__ __forceinline__ void operator()(int row, int col, float v, float rs) const {
    float x = v * rs;
    const int h = col / 96, d = col % 96;
    const float pv = __shfl_xor(x, 16);
    if (d >= 64 && row < NL) {
      const float2 cs = rope[(row % SEQ) * 16 + ((d - 64) & 15)];
      x = (d < 80) ? x * cs.x - pv * cs.y : pv * cs.y + x * cs.x;
    }
    x *= QSCALE;
    const float nb = __shfl_xor(x, 1);
    int b, kidx; row_bk(row, b, kidx);
    if (!(col & 1)) *(unsigned*)(Q + ((size_t)(b * 4 + h) * LK + kidx) * 96 + d) = pack_bf2(x, nb);
  }
};
struct EpiMlaKV {
  bf16_t* K; bf16_t* VT;
  __device__ __forceinline__ void operator()(int row, int col, float v, float rs) const {
    const float x = v * rs;
    const int h = col >> 7, j = col & 127;
    const float nb = __shfl_xor(x, 1);
    int b, kidx; row_bk(row, b, kidx);
    if (j < 64) { if (!(col & 1)) *(unsigned*)(K + ((size_t)(b * 4 + h) * LK + kidx) * 96 + j) = pack_bf2(x, nb); }
    else VT[((size_t)(b * 4 + h) * 64 + (j - 64)) * LK + kidx] = f2bf(x);
  }
};
__device__ __forceinline__ void mla_krope(int mt, int tid, const bf16_t* P, const float2* rope, bf16_t* K) {
#pragma unroll
  for (int it = 0; it < 4; ++it) {
    const int task = tid + 256 * it, rl = task >> 3, ip = (task & 7) * 2;
    const int row = mt * 128 + rl;
    const bf16_t* kr = P + (size_t)row * PLD + O_MLA + 384;
    const unsigned a = *(const unsigned*)(kr + ip), c2 = *(const unsigned*)(kr + 16 + ip);
    float x1[2] = {bflo(a), bfhi(a)}, x2[2] = {bflo(c2), bfhi(c2)}, o1[2], o2[2];
#pragma unroll
    for (int e = 0; e < 2; ++e) {
      float cs = 1.f, sn = 0.f;
      if (row < NL) { const float2 t = rope[(row % SEQ) * 16 + ip + e]; cs = t.x; sn = t.y; }
      o1[e] = x1[e] * cs - x2[e] * sn; o2[e] = x1[e] * sn + x2[e] * cs;
    }
    int b, kidx; row_bk(row, b, kidx);
#pragma unroll
    for (int h = 0; h < 4; ++h) {
      bf16_t* kk = K + ((size_t)(b * 4 + h) * LK + kidx) * 96 + 64;
      *(unsigned*)(kk + ip) = pack_bf2(o1[0], o1[1]); *(unsigned*)(kk + 16 + ip) = pack_bf2(o2[0], o2[1]);
    }
  }
}
__device__ __forceinline__ void attn_softmax(f16v& S, float& m, float& l, f16v& o0, f16v& o1, s8v& p0, s8v& p1) {
  float mx = S[0];
#pragma unroll
  for (int r = 1; r < 16; ++r) mx = fmaxf(mx, S[r]);
  mx = fmaxf(mx, __shfl_xor(mx, 32));
  const float mn = fmaxf(m, mx);
  const float al = exp2f(m - mn);
  m = mn;
  float ps = 0.f;
#pragma unroll
  for (int r = 0; r < 16; ++r) { const float pe = exp2f(S[r] - mn); S[r] = pe; ps += pe; }
  l = l * al + ps;
#pragma unroll
  for (int r = 0; r < 16; ++r) { o0[r] *= al; o1[r] *= al; }
  uint4 pk;
  pk.x = pack_bf2(S[0], S[1]); pk.y = pack_bf2(S[2], S[3]); pk.z = pack_bf2(S[4], S[5]); pk.w = pack_bf2(S[6], S[7]);
  p0 = __builtin_bit_cast(s8v, pk);
  pk.x = pack_bf2(S[8], S[9]); pk.y = pack_bf2(S[10], S[11]); pk.z = pack_bf2(S[12], S[13]); pk.w = pack_bf2(S[14], S[15]);
  p1 = __builtin_bit_cast(s8v, pk);
}
constexpr int AT_KROW = 208, AT_VROW = 136, AT_BUF = 64 * AT_KROW + 64 * AT_VROW;
__device__ __forceinline__ void attn_item(int item, int tid, char* smem, const bf16_t* Q, const bf16_t* K, const bf16_t* VT, bf16_t* CAT) {
  constexpr int NQB = LK / 256;
  const int bh = item / NQB, qblk = item % NQB;
  const int w = tid >> 6, lane = tid & 63, li = lane & 31, hl = lane >> 5;
  const int q0 = qblk * 256 + w * 64;
  const int key_lo = (qblk * 256 < SEQ) ? 0 : SEQ;
  const int ntile = (LK - key_lo) / 64;
  const bf16_t* Kb = K + (size_t)bh * LK * 96; const bf16_t* Vb = VT + (size_t)bh * 64 * LK;
  s8v qf[2][6];
#pragma unroll
  for (int qs = 0; qs < 2; ++qs)
#pragma unroll
    for (int s = 0; s < 6; ++s) qf[qs][s] = *(const s8v*)(Q + ((size_t)bh * LK + q0 + qs * 32 + li) * 96 + s * 16 + 8 * hl);
  f16v o[2][2];
  float m[2], l[2];
#pragma unroll
  for (int qs = 0; qs < 2; ++qs) {
    m[qs] = -1e30f; l[qs] = 0.f;
#pragma unroll
    for (int t = 0; t < 2; ++t)
#pragma unroll
      for (int r = 0; r < 16; ++r) o[qs][t][r] = 0.f;
  }
  uint4 rk0, rk1, rk2, rv0, rv1;
#define AT_LOAD(t_) do { const int k0_ = key_lo + (t_) * 64; \
    rk0 = *(const uint4*)(Kb + (size_t)k0_ * 96 + (tid) * 8); rk1 = *(const uint4*)(Kb + (size_t)k0_ * 96 + (tid + 256) * 8); rk2 = *(const uint4*)(Kb + (size_t)k0_ * 96 + (tid + 512) * 8); \
    rv0 = *(const uint4*)(Vb + (size_t)(tid >> 3) * LK + k0_ + (tid & 7) * 8); rv1 = *(const uint4*)(Vb + (size_t)((tid + 256) >> 3) * LK + k0_ + (tid & 7) * 8); } while (0)
#define AT_STORE(buf_) do { char* kb_ = smem + (buf_) * AT_BUF; char* vv_ = kb_ + 64 * AT_KROW; \
    *(uint4*)(kb_ + (tid / 12) * AT_KROW + (tid % 12) * 16) = rk0; *(uint4*)(kb_ + ((tid + 256) / 12) * AT_KROW + ((tid + 256) % 12) * 16) = rk1; \
    *(uint4*)(kb_ + ((tid + 512) / 12) * AT_KROW + ((tid + 512) % 12) * 16) = rk2; \
    { char* d_ = vv_ + (tid >> 3) * AT_VROW + (tid & 7) * 16; *(uint2*)d_ = make_uint2(rv0.x, rv0.y); *(uint2*)(d_ + 8) = make_uint2(rv0.z, rv0.w); } \
    { char* d_ = vv_ + ((tid + 256) >> 3) * AT_VROW + (tid & 7) * 16; *(uint2*)d_ = make_uint2(rv1.x, rv1.y); *(uint2*)(d_ + 8) = make_uint2(rv1.z, rv1.w); } } while (0)
  AT_LOAD(0); AT_STORE(0);
  __syncthreads();
  for (int t = 0; t < ntile; ++t) {
    const int buf = t & 1;
    if (t + 1 < ntile) AT_LOAD(t + 1);
    const char* kb = smem + buf * AT_BUF; const char* vb_ = kb + 64 * AT_KROW;
#pragma unroll
    for (int ks = 0; ks < 2; ++ks) {
      f16v S[2];
#pragma unroll
      for (int qs = 0; qs < 2; ++qs)
#pragma unroll
        for (int r = 0; r < 16; ++r) S[qs][r] = 0.f;
#pragma unroll
      for (int s = 0; s < 6; ++s) {
        const s8v kf = *(const s8v*)(kb + (ks * 32 + li) * AT_KROW + (2 * s + hl) * 16);
#pragma unroll
        for (int qs = 0; qs < 2; ++qs) S[qs] = __builtin_amdgcn_mfma_f32_32x32x16_bf16(kf, qf[qs][s], S[qs], 0, 0, 0);
      }
      s8v pa0, pa1, pb0, pb1;
      attn_softmax(S[0], m[0], l[0], o[0][0], o[0][1], pa0, pa1);
      attn_softmax(S[1], m[1], l[1], o[1][0], o[1][1], pb0, pb1);
#pragma unroll
      for (int sp = 0; sp < 2; ++sp)
#pragma unroll
        for (int tt = 0; tt < 2; ++tt) {
          const char* vr = vb_ + (tt * 32 + li) * AT_VROW + (ks * 32 + 16 * sp + 4 * hl) * 2;
          const uint2 lo = *(const uint2*)vr, hi = *(const uint2*)(vr + 16);
          uint4 va; va.x = lo.x; va.y = lo.y; va.z = hi.x; va.w = hi.y;
          const s8v vf = __builtin_bit_cast(s8v, va);
          o[0][tt] = __builtin_amdgcn_mfma_f32_32x32x16_bf16(vf, sp ? pa1 : pa0, o[0][tt], 0, 0, 0);
          o[1][tt] = __builtin_amdgcn_mfma_f32_32x32x16_bf16(vf, sp ? pb1 : pb0, o[1][tt], 0, 0, 0);
        }
    }
    if (t + 1 < ntile) AT_STORE(buf ^ 1);
    __syncthreads();
  }
#undef AT_LOAD
#undef AT_STORE
  const int b = bh >> 2, h = bh & 3;
#pragma unroll
  for (int qs = 0; qs < 2; ++qs) {
    const float lt = l[qs] + __shfl_xor(l[qs], 32);
    const float il = 1.f / lt;
    const int qi = q0 + qs * 32 + li;
    const size_t row = (qi < SEQ) ? (size_t)b * SEQ + qi : (size_t)NL + (size_t)b * CTX + (qi - SEQ);
#pragma unroll
    for (int tt = 0; tt < 2; ++tt)
#pragma unroll
      for (int q4 = 0; q4 < 4; ++q4) {
        const int dv = tt * 32 + 8 * q4 + 4 * hl;
        uint2 pk; pk.x = pack_bf2(o[qs][tt][q4 * 4 + 0] * il, o[qs][tt][q4 * 4 + 1] * il); pk.y = pack_bf2(o[qs][tt][q4 * 4 + 2] * il, o[qs][tt][q4 * 4 + 3] * il);
        *(uint2*)(CAT + row * DM + 512 + h * 64 + dv) = pk;
      }
  }
}
struct S5Consts { float ar, ai; float bbr[16], bbi[16]; };
__device__ __forceinline__ void s5_consts(S5Consts& k, int dir, int g, int n, const float* a_re, const float* a_im, const float* log_dt,
                                          const float* b_re, const float* b_im) {
  const float lre = fminf(a_re[(dir * 16 + g) * 64 + n], -1e-4f), lim = a_im[(dir * 16 + g) * 64 + n];
  const float step = expf(log_dt[dir * 16 + g]);
  const float er = expf(lre * step);
  k.ar = er * cosf(lim * step); k.ai = er * sinf(lim * step);
  const float nr = k.ar - 1.f, ni = k.ai, den = lre * lre + lim * lim;
  const float cr = (nr * lre + ni * lim) / den, ci = (ni * lre - nr * lim) / den;
#pragma unroll
  for (int c = 0; c < 16; ++c) {
    const float br = b_re[(g * 64 + n) * 16 + c], bi = b_im[(g * 64 + n) * 16 + c];
    k.bbr[c] = cr * br - ci * bi; k.bbi[c] = cr * bi + ci * br;
  }
}
__device__ __forceinline__ void s5_load_u(float* u, const bf16_t* P, int r, int g) {
  const uint4* p4 = (const uint4*)(P + (size_t)r * PLD + O_S5 + g * 16);
  const uint4 a = p4[0], b = p4[1];
  u[0] = bflo(a.x); u[1] = bfhi(a.x); u[2] = bflo(a.y); u[3] = bfhi(a.y); u[4] = bflo(a.z); u[5] = bfhi(a.z); u[6] = bflo(a.w); u[7] = bfhi(a.w);
  u[8] = bflo(b.x); u[9] = bfhi(b.x); u[10] = bflo(b.y); u[11] = bfhi(b.y); u[12] = bflo(b.z); u[13] = bfhi(b.z); u[14] = bflo(b.w); u[15] = bfhi(b.w);
}
__device__ __forceinline__ void s5_cct(int vb, int tid, const float* c_re, const float* c_im, bf16_t* CCT) {
  const int idx = vb * 256 + tid; if (idx >= 2 * 16 * 16 * 128) return;
  const int np = idx & 127, dgc = idx >> 7;
  CCT[idx] = f2bf(np < 64 ? c_re[dgc * 64 + np] : -c_im[dgc * 64 + np - 64]);
}
__device__ __forceinline__ void s5_A(int item, int tid, const bf16_t* P, const float* a_re, const float* a_im, const float* log_dt,
                                     const float* b_re, const float* b_im, float2* END) {
  const int gq = item & 3, dir = (item >> 2) & 1, c = (item >> 3) % NCH64, b = (item >> 3) / NCH64;
  const int g = gq * 4 + (tid >> 6), n = tid & 63;
  const int row0 = chunk64_row0(b, c);
  S5Consts k; s5_consts(k, dir, g, n, a_re, a_im, log_dt, b_re, b_im);
  float hr = 0.f, hi = 0.f;
#pragma unroll 4
  for (int s = 0; s < 64; ++s) {
    const int t = dir ? 63 - s : s;
    float u[16]; s5_load_u(u, P, row0 + t, g);
    float bur = 0.f, bui = 0.f;
#pragma unroll
    for (int cc = 0; cc < 16; ++cc) { bur += u[cc] * k.bbr[cc]; bui += u[cc] * k.bbi[cc]; }
    const float nhr = k.ar * hr - k.ai * hi + bur, nhi = k.ar * hi + k.ai * hr + bui;
    hr = nhr; hi = nhi;
  }
  END[((size_t)((b * 2 + dir) * 16 + g) * NCH64 + c) * 64 + n] = make_float2(hr, hi);
}
__device__ __forceinline__ void s5_B(int vb, int tid, const float* a_re, const float* a_im, const float* log_dt, float2* END) {
  const int idx = vb * 256 + tid; if (idx >= NB * 2 * 16 * 64) return;
  const int n = idx & 63, g = (idx >> 6) & 15, dir = (idx >> 10) & 1;
  const float lre = fminf(a_re[(dir * 16 + g) * 64 + n], -1e-4f), lim = a_im[(dir * 16 + g) * 64 + n];
  const float step = expf(log_dt[dir * 16 + g]) * 64.f;
  const float er = expf(lre * step);
  const float ar = er * cosf(lim * step), ai = er * sinf(lim * step);
  float rr = 0.f, ri = 0.f;
  float2* base = END + (size_t)(idx >> 6) * NCH64 * 64 + n;
  for (int kk = 0; kk < NCH64; ++kk) {
    const int c = chain64(dir, kk);
    const float2 loc = base[(size_t)c * 64];
    base[(size_t)c * 64] = make_float2(rr, ri);
    const float nr = ar * rr - ai * ri + loc.x, ni = ar * ri + ai * rr + loc.y;
    rr = nr; ri = ni;
  }
}
__device__ __forceinline__ void s5_C(int item, int tid, char* smem, const bf16_t* P, const float* a_re, const float* a_im, const float* log_dt,
                                     const float* b_re, const float* b_im, const bf16_t* CCT, const float* d_skip, const bf16_t* WT_GLU,
                                     const float* glu_b, const float2* SIN, bf16_t* CAT) {
  const int c = item % NCH64, b = item / NCH64;
  const int w = tid >> 6, lane = tid & 63, n = lane;
  const int row0 = chunk64_row0(b, c);
  bf16_t* HB = (bf16_t*)(smem + w * 8192);
  char* Y = smem + 32768;
  for (int gi = 0; gi < 4; ++gi) {
    const int g = w * 4 + gi;
    f4v acc[4];
#pragma unroll
    for (int i = 0; i < 4; ++i) acc[i] = (f4v){0.f, 0.f, 0.f, 0.f};
    for (int dir = 0; dir < 2; ++dir) {
      S5Consts k; s5_consts(k, dir, g, n, a_re, a_im, log_dt, b_re, b_im);
      const float2 h0 = SIN[((size_t)((b * 2 + dir) * 16 + g) * NCH64 + c) * 64 + n];
      float hr = h0.x, hi = h0.y;
      for (int half = 0; half < 2; ++half) {
#pragma unroll 4
        for (int s = 0; s < 32; ++s) {
          const int st = half * 32 + s; const int t = dir ? 63 - st : st;
          float u[16]; s5_load_u(u, P, row0 + t, g);
          float bur = 0.f, bui = 0.f;
#pragma unroll
          for (int cc = 0; cc < 16; ++cc) { bur += u[cc] * k.bbr[cc]; bui += u[cc] * k.bbi[cc]; }
          const float nhr = k.ar * hr - k.ai * hi + bur, nhi = k.ar * hi + k.ai * hr + bui;
          hr = nhr; hi = nhi;
          HB[(t & 31) * 128 + n] = f2bf(hr); HB[(t & 31) * 128 + 64 + n] = f2bf(hi);
        }
        __syncthreads();
        const int thalf = dir ? 1 - half : half;
        const bf16_t* cc = CCT + (size_t)((dir * 16 + g) * 16 + (lane & 15)) * 128;
#pragma unroll
        for (int ks = 0; ks < 4; ++ks) {
          const s8v bfr = *(const s8v*)(cc + ks * 32 + (lane >> 4) * 8);
#pragma unroll
          for (int tt = 0; tt < 2; ++tt) {
            const s8v af = *(const s8v*)(HB + (tt * 16 + (lane & 15)) * 128 + ks * 32 + (lane >> 4) * 8);
            acc[thalf * 2 + tt] = __builtin_amdgcn_mfma_f32_16x16x32_bf16(af, bfr, acc[thalf * 2 + tt], 0, 0, 0);
          }
        }
        __syncthreads();
      }
    }
    const int cch = g * 16 + (lane & 15);
    const float dsk = d_skip[cch];
#pragma unroll
    for (int i = 0; i < 4; ++i)
#pragma unroll
      for (int r = 0; r < 4; ++r) {
        const int t = i * 16 + (lane >> 4) * 4 + r;
        const float y = geluf(acc[i][r] + dsk * bf2f(P[(size_t)(row0 + t) * PLD + O_S5 + cch]));
        *(bf16_t*)(Y + t * 512 + (((cch >> 3) ^ (t & 31)) << 4) + (cch & 7) * 2) = f2bf(y);
      }
  }
  __syncthreads();
  f16v ga[2][2];
#pragma unroll
  for (int i = 0; i < 2; ++i)
#pragma unroll
    for (int j = 0; j < 2; ++j)
#pragma unroll
      for (int r = 0; r < 16; ++r) ga[i][j][r] = 0.f;
#pragma unroll 4
  for (int ks = 0; ks < 16; ++ks) {
    s8v af[2], bfr[2];
    const int ch = ks * 2 + (lane >> 5);
#pragma unroll
    for (int i = 0; i < 2; ++i) {
      const int t = i * 32 + (lane & 31);
      af[i] = *(const s8v*)(Y + t * 512 + ((ch ^ (t & 31)) << 4));
      bfr[i] = *(const s8v*)(WT_GLU + (size_t)(w * 64 + i * 32 + (lane & 31)) * 256 + ch * 8);
    }
#pragma unroll
    for (int i = 0; i < 2; ++i)
#pragma unroll
      for (int j = 0; j < 2; ++j) ga[i][j] = __builtin_amdgcn_mfma_f32_32x32x16_bf16(af[i], bfr[j], ga[i][j], 0, 0, 0);
  }
#pragma unroll
  for (int i = 0; i < 2; ++i)
#pragma unroll
    for (int j = 0; j < 2; ++j) {
      const int col = w * 64 + j * 32 + (lane & 31);
      const float gbias = glu_b[col];
#pragma unroll
      for (int r = 0; r < 16; ++r) {
        const int t = i * 32 + (r & 3) + 8 * (r >> 2) + 4 * (lane >> 5);
        const float y = bf2f(*(const bf16_t*)(Y + t * 512 + (((col >> 3) ^ (t & 31)) << 4) + (col & 7) * 2));
        { const float ov = y * sigmoidf_(ga[i][j][r] + gbias); const float onb = __shfl_xor(ov, 1);
          if (!(lane & 1)) *(unsigned*)(CAT + (size_t)(row0 + t) * DM + 768 + col) = pack_bf2(ov, onb); }
      }
    }
  __syncthreads();
}
#ifdef EMU
static inline int rlane_i(int v, int k) { return __shfl(v, k); }
static inline float rlane_f(float v, int k) { return __shfl(v, k); }
#else
__device__ __forceinline__ int rlane_i(int v, int k) { return __builtin_amdgcn_readlane(v, k); }
__device__ __forceinline__ float rlane_f(float v, int k) { return __uint_as_float((unsigned)__builtin_amdgcn_readlane((int)__float_as_uint(v), k)); }
#endif
__device__ __forceinline__ void d_cvt_bf16(int vb, int tid, const float* src, bf16_t* dst, size_t n8) {
  const size_t i = (size_t)vb * 256 + tid; if (i >= n8) return;
  const float4 a = *(const float4*)(src + i * 8), b = *(const float4*)(src + i * 8 + 4);
  uint4 o; o.x = pack_bf2(a.x, a.y); o.y = pack_bf2(a.z, a.w); o.z = pack_bf2(b.x, b.y); o.w = pack_bf2(b.z, b.w);
  *(uint4*)(dst + i * 8) = o;
}
__device__ __forceinline__ void top16_insert(float (&L)[16], float x) {
#pragma unroll
  for (int i = 0; i < 16; ++i) { const float hi = fmaxf(L[i], x); x = fminf(L[i], x); L[i] = hi; }
}
__device__ __forceinline__ float pk_idx(float v, unsigned idx, unsigned mask) { return __uint_as_float((__float_as_uint(v) & ~mask) | idx); }
struct EpiPeerQ {
  char* qt; const float* bias; int m0, n0;
  __device__ __forceinline__ void operator()(int row, int col, float v, float rs) const {
    const float val = rs * v + bias[row_mod(row) * DM + col];
    const float nb = __shfl_xor(val, 1);
    const int rl = row - m0, cl = col - n0;
    if (!(cl & 1)) *(unsigned*)(qt + rl * 256 + (((cl >> 3) ^ (rl & 15)) << 4) + (cl & 7) * 2) = pack_bf2(val, nb);
  }
};
__device__ __forceinline__ void peer_route(int mt, int h, int tid, char* smem, const float* H, const float* gain, const bf16_t* Wt, const float* bias,
                                           const bf16_t* SKB, int* EIDX, float* GATE) {
  const int m0 = mt * 128;
  char* qt = smem + 65536;
  { EpiPeerQ epi{qt, bias, m0, h * 128}; gemm128<true, true>(tid, smem, H, DM, gain + row_mod(m0) * DM, Wt, DM, DM, m0, h * 128, epi); }
  const int w = tid >> 6, lane = tid & 63, li = lane & 31, hl = lane >> 5;
  const int tl = w * 32 + li;
  float L[2][16];
#pragma unroll
  for (int half = 0; half < 2; ++half) {
    f16v acc[4];
#pragma unroll
    for (int kt = 0; kt < 4; ++kt)
#pragma unroll
      for (int r = 0; r < 16; ++r) acc[kt][r] = 0.f;
#pragma unroll
    for (int s = 0; s < 4; ++s) {
      const int c = half * 8 + 2 * s + hl;
      const s8v qf = *(const s8v*)(qt + tl * 256 + ((c ^ (tl & 15)) << 4));
#pragma unroll
      for (int kt = 0; kt < 4; ++kt) {
        const s8v kf = *(const s8v*)(SKB + ((size_t)(half * 8 + h) * 128 + kt * 32 + li) * 64 + s * 16 + 8 * hl);
        acc[kt] = __builtin_amdgcn_mfma_f32_32x32x16_bf16(kf, qf, acc[kt], 0, 0, 0);
      }
    }
#pragma unroll
    for (int i = 0; i < 16; ++i) L[half][i] = -3.0e38f;
#pragma unroll
    for (int kt = 0; kt < 4; ++kt)
#pragma unroll
      for (int r = 0; r < 16; ++r) {
        const unsigned key = kt * 32 + (r & 3) + 8 * (r >> 2) + 4 * hl;
        top16_insert(L[half], pk_idx(acc[kt][r], key, 0x7Fu));
      }
    float other[16];
#pragma unroll
    for (int i = 0; i < 16; ++i) other[i] = __shfl_xor(L[half][i], 32);
#pragma unroll
    for (int i = 0; i < 16; ++i) top16_insert(L[half], other[i]);
  }
  float C[16];
#pragma unroll
  for (int i = 0; i < 16; ++i) C[i] = -3.0e38f;
#pragma unroll
  for (int a = 0; a < 16; ++a)
#pragma unroll
    for (int b = 0; b < 16; ++b)
      if ((a + 1) * (b + 1) <= 16) {
        const float s = __uint_as_float(__float_as_uint(L[0][a]) & ~0x7Fu) + __uint_as_float(__float_as_uint(L[1][b]) & ~0x7Fu);
        top16_insert(C, pk_idx(s, (unsigned)(a * 16 + b), 0xFFu));
      }
  unsigned char* kidx = (unsigned char*)smem + w * 1024 + li * 32;
  if (hl == 0) {
#pragma unroll
    for (int i = 0; i < 16; ++i) { kidx[i] = (unsigned char)(__float_as_uint(L[0][i]) & 0x7Fu); kidx[16 + i] = (unsigned char)(__float_as_uint(L[1][i]) & 0x7Fu); }
  }
  __syncthreads();
  if (hl == 0) {
    const float mx = __uint_as_float(__float_as_uint(C[0]) & ~0xFFu);
    float e[16], sum = 0.f;
#pragma unroll
    for (int i = 0; i < 16; ++i) { e[i] = expf(__uint_as_float(__float_as_uint(C[i]) & ~0xFFu) - mx); sum += e[i]; }
    const float inv = 1.f / sum;
    int ex[16];
#pragma unroll
    for (int i = 0; i < 16; ++i) { const unsigned code = __float_as_uint(C[i]) & 0xFFu; ex[i] = (int)kidx[code >> 4] * 128 + (int)kidx[16 + (code & 15)]; }
    const size_t o = ((size_t)h * NT + m0 + tl) * 16;
#pragma unroll
    for (int q = 0; q < 4; ++q) {
      *(int4*)(EIDX + o + q * 4) = int4{ex[q * 4], ex[q * 4 + 1], ex[q * 4 + 2], ex[q * 4 + 3]};
      *(float4*)(GATE + o + q * 4) = make_float4(e[q * 4] * inv, e[q * 4 + 1] * inv, e[q * 4 + 2] * inv, e[q * 4 + 3] * inv);
    }
  }
  __syncthreads();
}
template <bool LAST>
__device__ __forceinline__ void peer_gather(int row, int lane, const float* GFFl, const float* mod, const int* EIDX, const float* GATE,
                                            const bf16_t* UB, const bf16_t* VB, float* H, const float* fin_g, float* out) {
  const int g = lane >> 3, j = lane & 7;
  const int mb = row_mod(row);
  const float* hrow = H + (size_t)row * DM;
  float f[128];
  float ss = 0.f;
#pragma unroll
  for (int c = 0; c < 16; ++c) {
    const float4 a = *(const float4*)(hrow + c * 64 + j * 8), b = *(const float4*)(hrow + c * 64 + j * 8 + 4);
    f[c * 8 + 0] = a.x; f[c * 8 + 1] = a.y; f[c * 8 + 2] = a.z; f[c * 8 + 3] = a.w; f[c * 8 + 4] = b.x; f[c * 8 + 5] = b.y; f[c * 8 + 6] = b.z; f[c * 8 + 7] = b.w;
  }
#pragma unroll
  for (int i = 0; i < 128; ++i) ss += f[i] * f[i];
  ss += __shfl_xor(ss, 1); ss += __shfl_xor(ss, 2); ss += __shfl_xor(ss, 4);
  const float rs = rsqrtf(ss * (1.f / DM) + EPS);
  {
    const float* gg = GFFl + mb * DM; const float* sh = mod + mb * NMOD * DM + 3 * DM;
#pragma unroll
    for (int c = 0; c < 16; ++c) {
      const float4 ga = *(const float4*)(gg + c * 64 + j * 8), gb = *(const float4*)(gg + c * 64 + j * 8 + 4);
      const float4 sa = *(const float4*)(sh + c * 64 + j * 8), sb = *(const float4*)(sh + c * 64 + j * 8 + 4);
      f[c * 8 + 0] = f[c * 8 + 0] * rs * ga.x + sa.x; f[c * 8 + 1] = f[c * 8 + 1] * rs * ga.y + sa.y; f[c * 8 + 2] = f[c * 8 + 2] * rs * ga.z + sa.z; f[c * 8 + 3] = f[c * 8 + 3] * rs * ga.w + sa.w;
      f[c * 8 + 4] = f[c * 8 + 4] * rs * gb.x + sb.x; f[c * 8 + 5] = f[c * 8 + 5] * rs * gb.y + sb.y; f[c * 8 + 6] = f[c * 8 + 6] * rs * gb.z + sb.z; f[c * 8 + 7] = f[c * 8 + 7] * rs * gb.w + sb.w;
    }
  }
  int ev[16]; float wv[16];
#pragma unroll
  for (int i = 0; i < 16; ++i) {
    const size_t o = ((size_t)(i >> 1) * NT + row) * 16 + (i & 1) * 8 + g;
    ev[i] = EIDX[o]; wv[i] = GATE[o];
  }
#pragma unroll 2
  for (int i = 0; i < 16; ++i) {
    const bf16_t* u = UB + (size_t)ev[i] * DM + j * 8;
    float acc = 0.f;
#pragma unroll
    for (int c = 0; c < 16; ++c) {
      const uint4 q = *(const uint4*)(u + c * 64);
      acc += f[c * 8 + 0] * bflo(q.x) + f[c * 8 + 1] * bfhi(q.x) + f[c * 8 + 2] * bflo(q.y) + f[c * 8 + 3] * bfhi(q.y)
           + f[c * 8 + 4] * bflo(q.z) + f[c * 8 + 5] * bfhi(q.z) + f[c * 8 + 6] * bflo(q.w) + f[c * 8 + 7] * bfhi(q.w);
    }
    acc += __shfl_xor(acc, 1); acc += __shfl_xor(acc, 2); acc += __shfl_xor(acc, 4);
    wv[i] *= geluf(acc);
  }
  float o16[16];
#pragma unroll
  for (int i = 0; i < 16; ++i) o16[i] = 0.f;
#pragma unroll 4
  for (int k = 0; k < 128; ++k) {
    const int e = rlane_i(ev[k >> 3], (k & 7) * 8); const float wk = rlane_f(wv[k >> 3], (k & 7) * 8);
    const bf16_t* v = VB + (size_t)e * DM + lane * 16;
    const uint4 a = *(const uint4*)v, b = *(const uint4*)(v + 8);
    o16[0] += wk * bflo(a.x); o16[1] += wk * bfhi(a.x); o16[2] += wk * bflo(a.y); o16[3] += wk * bfhi(a.y);
    o16[4] += wk * bflo(a.z); o16[5] += wk * bfhi(a.z); o16[6] += wk * bflo(a.w); o16[7] += wk * bfhi(a.w);
    o16[8] += wk * bflo(b.x); o16[9] += wk * bfhi(b.x); o16[10] += wk * bflo(b.y); o16[11] += wk * bfhi(b.y);
    o16[12] += wk * bflo(b.z); o16[13] += wk * bfhi(b.z); o16[14] += wk * bflo(b.w); o16[15] += wk * bfhi(b.w);
  }
  const float* m5 = mod + mb * NMOD * DM + 5 * DM + lane * 16;
  float hn[16]; float s2 = 0.f;
#pragma unroll
  for (int q = 0; q < 4; ++q) {
    const float4 hv = *(const float4*)(hrow + lane * 16 + q * 4), mv = *(const float4*)(m5 + q * 4);
    hn[q * 4 + 0] = hv.x + mv.x * o16[q * 4 + 0]; hn[q * 4 + 1] = hv.y + mv.y * o16[q * 4 + 1];
    hn[q * 4 + 2] = hv.z + mv.z * o16[q * 4 + 2]; hn[q * 4 + 3] = hv.w + mv.w * o16[q * 4 + 3];
  }
  if (LAST) {
#pragma unroll
    for (int i = 0; i < 16; ++i) s2 += hn[i] * hn[i];
    s2 = wave_sum(s2);
    const float r2 = rsqrtf(s2 * (1.f / DM) + EPS);
#pragma unroll
    for (int q = 0; q < 4; ++q) {
      const float4 gv = *(const float4*)(fin_g + lane * 16 + q * 4);
      *(float4*)(out + (size_t)row * DM + lane * 16 + q * 4) = make_float4(hn[q * 4] * r2 * gv.x, hn[q * 4 + 1] * r2 * gv.y, hn[q * 4 + 2] * r2 * gv.z, hn[q * 4 + 3] * r2 * gv.w);
    }
  } else {
#pragma unroll
    for (int q = 0; q < 4; ++q) *(float4*)(H + (size_t)row * DM + lane * 16 + q * 4) = make_float4(hn[q * 4], hn[q * 4 + 1], hn[q * 4 + 2], hn[q * 4 + 3]);
  }
}
__device__ __forceinline__ void d_final(int vb, int tidp, char* smem, const float* H, const float* g, float* out) {
  int row = (vb * 256 + tidp) / 64, lane = tidp & 63;
  if (row >= NL) return;
  const float* h = H + (size_t)row * DM;
  float ss = 0.f;
  for (int k = lane; k < DM; k += 64) ss += h[k] * h[k];
  ss = wave_sum(ss);
  float rs = rsqrtf(ss / DM + EPS);
  for (int k = lane; k < DM; k += 64) out[(size_t)row * DM + k] = h[k] * rs * g[k];
}

constexpr int LDS_BYTES = 98304 + 256;
#ifdef EMU_STOP_L0C
static float* g_dbg_cat = nullptr;
#endif
struct Params {
  const float* in[38];
  float* out;
  char* ws;
};
#ifdef EMU
#define TID() ((int)threadIdx.x)
#else
__device__ __forceinline__ int opaque_tid() { int t = threadIdx.x; asm volatile("" : "+v"(t)); return t; }
#define TID() opaque_tid()
#endif
#define FOR_VB(n) for (int vb = blockIdx.x, nvb_ = (n); vb < nvb_; vb += gridDim.x)
__device__ __forceinline__ int cdivd(size_t a, size_t b) { return (int)((a + b - 1) / b); }

__global__ void __launch_bounds__(256, 1) mega(Params p) {
#ifdef EMU
  char* smem = emu_block_smem();
#else
  extern __shared__ __attribute__((aligned(16))) char smem[];
#endif
  const float* x = p.in[0];       const float* c = p.in[1];
  const float* ctx = p.in[2];     const float* c_ctx = p.in[3];
  const float* ada_w = p.in[4];   const float* ada_b = p.in[5];
  const float* norm_mix_g = p.in[6]; const float* norm_ffn_g = p.in[7];
  const float* w_in = p.in[8];    const float* w_out = p.in[9];
  const float* ssd_conv_w = p.in[10]; const float* ssd_conv_b = p.in[11];
  const float* ssd_a_log = p.in[12];  const float* ssd_dt_bias = p.in[13];
  const float* ssd_d = p.in[14];  const float* ssd_norm_g = p.in[15];
  const float* gla_gate_w = p.in[16]; const float* gla_gate_b = p.in[17];
  const float* gla_norm_g = p.in[18]; const float* mla_q_norm_g = p.in[19];
  const float* mla_w_uq = p.in[20];   const float* mla_kv_norm_g = p.in[21];
  const float* mla_w_ukv = p.in[22];  const float* s5_a_re = p.in[23];
  const float* s5_a_im = p.in[24];    const float* s5_log_dt = p.in[25];
  const float* s5_b_re = p.in[26];    const float* s5_b_im = p.in[27];
  const float* s5_c_re = p.in[28];    const float* s5_c_im = p.in[29];
  const float* s5_d = p.in[30];       const float* s5_glu_w = p.in[31];
  const float* s5_glu_b = p.in[32];   const float* peer_w_q = p.in[33];
  const float* peer_sub_keys = p.in[34]; const float* peer_u = p.in[35];
  const float* peer_v = p.in[36];     const float* final_norm_g = p.in[37];
  float* out = p.out;

  char* wp = p.ws; size_t off = 16384;
#ifndef EMU
  const XBar xbar = xbar_init((unsigned*)p.ws, (volatile unsigned*)(smem + 98304));
  cooperative_groups::this_grid().sync();
#endif
  auto carve = [&](size_t nbytes) { char* q = wp + off; off += ((nbytes + 255) / 256) * 256; return q; };
  float* MOD = (float*)carve((size_t)2 * 3 * NMOD * DM * 4);
  float* H = (float*)carve((size_t)NT * DM * 4);
  bf16_t* P = (bf16_t*)carve((size_t)NT * PLD * 2);
  float* PF = (float*)carve((size_t)NB * 2 * 4 * NCH128 * 8192 * 6);
  bf16_t* XBC = (bf16_t*)carve((size_t)NT * 768 * 2);
  bf16_t* XT = (bf16_t*)carve((size_t)NT * 256 * 2);
  float* SSD_DA = (float*)carve((size_t)NB * NCH128 * 2 * 4 * 2 * 128 * 4);

  bf16_t* CAT = (bf16_t*)carve((size_t)NT * DM * 2);
  float* GLA_ST = (float*)carve((size_t)NB * 2 * 4 * NCH64 * 2048 * 4);
  float* GLA_GP = (float*)carve((size_t)NB * 2 * 4 * NCH64 * 32 * 4);
  bf16_t* Q = (bf16_t*)carve((size_t)NB * 4 * LK * 96 * 2);
  bf16_t* K = (bf16_t*)carve((size_t)NB * 4 * LK * 96 * 2);
  bf16_t* VT = (bf16_t*)carve((size_t)NB * 4 * 64 * LK * 2);
  float2* ROPE = (float2*)carve((size_t)SEQ * 16 * 8);
  int* EIDX = (int*)carve((size_t)8 * NT * 16 * 4);
  float* GATE = (float*)carve((size_t)8 * NT * 16 * 4);
  bf16_t* SKB = (bf16_t*)carve((size_t)2 * 2 * 8 * 128 * 64 * 2);
  bf16_t* UB = (bf16_t*)carve((size_t)2 * 16384 * DM * 2);
  bf16_t* VB = (bf16_t*)carve((size_t)2 * 16384 * DM * 2);
  bf16_t* WT_IN = (bf16_t*)carve((size_t)2 * 2560 * DM * 2);
  bf16_t* WT_OUT = (bf16_t*)carve((size_t)2 * DM * DM * 2);
  bf16_t* WT_PQ = (bf16_t*)carve((size_t)2 * DM * DM * 2);
  bf16_t* WT_UQ = (bf16_t*)carve((size_t)2 * 384 * 256 * 2);
  bf16_t* WT_UKV = (bf16_t*)carve((size_t)2 * 512 * 128 * 2);
  bf16_t* WT_GLU = (bf16_t*)carve((size_t)2 * 256 * 256 * 2);
  float2* S5_ST = (float2*)carve((size_t)NB * 2 * 16 * NCH64 * 64 * 8);
  bf16_t* S5_CCT = (bf16_t*)carve((size_t)2 * 2 * 16 * 16 * 128 * 2);
  float* TIN = (float*)carve((size_t)2 * 3 * 2560 * 4);
  float* TPQ = (float*)carve((size_t)2 * 3 * DM * 4);
  float* GIN = (float*)carve((size_t)2 * 3 * DM * 4);
  float* GFF = (float*)carve((size_t)2 * 3 * DM * 4);
  float* SSD_ST = PF; bf16_t* SSD_HIN = (bf16_t*)(PF + (size_t)NB * 2 * 4 * NCH128 * 8192);

  FOR_VB(cdivd(2 * 3 * NMOD * DM, 256)) d_mod(vb, TID(), smem, c, c_ctx, ada_w, ada_b, MOD);
  FOR_VB(cdivd((size_t)NT * DM, 256)) d_copy_h(vb, TID(), smem, x, ctx, H);
  {
    const int n_in = 16 * 40, n_sq = 16 * 16, n_uq = 4 * 6, n_ukv = 2 * 8, n_glu = 4 * 4;
    const int per_l = n_in + 2 * n_sq + n_uq + n_ukv + n_glu;
    FOR_VB(2 * per_l) {
      int l = vb / per_l, v = vb % per_l; int tid = TID();
      if (v < n_in) { d_transpose_w(v, tid, smem, w_in + (size_t)l * DM * DIN, WT_IN + (size_t)l * 2560 * DM, DM, DIN, 2560); continue; }
      v -= n_in;
      if (v < n_sq) { d_transpose_w(v, tid, smem, w_out + (size_t)l * DM * DM, WT_OUT + (size_t)l * DM * DM, DM, DM, DM); continue; }
      v -= n_sq;
      if (v < n_sq) { d_transpose_w(v, tid, smem, peer_w_q + (size_t)l * DM * DM, WT_PQ + (size_t)l * DM * DM, DM, DM, DM); continue; }
      v -= n_sq;
      if (v < n_uq) { d_transpose_wg(v, tid, smem, mla_w_uq + (size_t)l * 256 * 384, mla_q_norm_g + l * 256, WT_UQ + (size_t)l * 384 * 256, 256, 384); continue; }
      v -= n_uq;
      if (v < n_ukv) { d_transpose_wg(v, tid, smem, mla_w_ukv + (size_t)l * 128 * 512, mla_kv_norm_g + l * 128, WT_UKV + (size_t)l * 512 * 128, 128, 512); continue; }
      v -= n_ukv;
      d_transpose_w(v, tid, smem, s5_glu_w + (size_t)l * 65536, WT_GLU + (size_t)l * 65536, 256, 256, 256);
    }
  }
  FOR_VB(SEQ * 16 / 256) d_rope_tab(vb, TID(), ROPE);
  FOR_VB(2 * 2 * 8 * 128 * 64 / 8 / 256) d_cvt_bf16(vb, TID(), peer_sub_keys, SKB, (size_t)2 * 2 * 8 * 128 * 64 / 8);
  FOR_VB(2 * 16384 * DM / 8 / 256) d_cvt_bf16(vb, TID(), peer_u, UB, (size_t)2 * 16384 * DM / 8);
  FOR_VB(2 * 16384 * DM / 8 / 256) d_cvt_bf16(vb, TID(), peer_v, VB, (size_t)2 * 16384 * DM / 8);
  FOR_VB(2 * 256) { int l = vb / 256; s5_cct(vb % 256, TID(), s5_c_re + l * 32768, s5_c_im + l * 32768, S5_CCT + (size_t)l * 65536); }
  GRID_SYNC();
  {
    const int n_tin = cdivd(3 * DIN, 256), n_tpq = cdivd(3 * DM, 256), n_g = cdivd(3 * DM, 256);
    const int per_l = n_tin + n_tpq + 2 * n_g;
    FOR_VB(2 * per_l) {
      int l = vb / per_l, v = vb % per_l; int tid = TID();
      const float* mod = MOD + (size_t)l * 3 * NMOD * DM;
      if (v < n_tin) { d_shiftvec(v, tid, w_in + (size_t)l * DM * DIN, DIN, mod, 0, TIN + l * 3 * 2560, 2560); continue; }
      v -= n_tin;
      if (v < n_tpq) { d_shiftvec(v, tid, peer_w_q + (size_t)l * DM * DM, DM, mod, 3, TPQ + l * 3 * DM, DM); continue; }
      v -= n_tpq;
      if (v < n_g) { d_gainvec(v, tid, norm_mix_g + l * DM, mod, 1, GIN + l * 3 * DM); continue; }
      v -= n_g;
      d_gainvec(v, tid, norm_ffn_g + l * DM, mod, 4, GFF + l * 3 * DM);
    }
  }
  GRID_SYNC();
#pragma unroll 1
  for (int l = 0; l < 2; ++l) {
    const float* mod = MOD + (size_t)l * 3 * NMOD * DM;
    const int nact = (l == 0) ? NT : NL;
    FOR_VB(20 * (NT / 128)) {
      int tid = TID(); int mt = vb / 20, nt = vb % 20; int m0 = mt * 128;
      EpiStoreBf16 epi{P, PLD, TIN + l * 3 * 2560, 2560};
      gemm128<true, true>(tid, smem, H, DM, GIN + l * 3 * DM + row_mod(m0) * DM, WT_IN + (size_t)l * 2560 * DM, DM, DM, m0, nt * 128, epi);
    }
    GRID_SYNC();
    FOR_VB(NB * NCH128 * 4) ssd_A(vb, TID(), smem, P, ssd_conv_w + l * 5 * 768, ssd_conv_b + l * 768, ssd_a_log + l * 8, ssd_dt_bias + l * 8, XBC, XT, SSD_DA, SSD_ST);
    FOR_VB(NB * NCH64 * 8) s5_A(vb, TID(), P, s5_a_re + l * 2048, s5_a_im + l * 2048, s5_log_dt + l * 32, s5_b_re + l * 16384, s5_b_im + l * 16384, S5_ST);
    FOR_VB(NB * NCH64 * 2) gla_A(vb, TID(), smem, P, gla_gate_w + l * 2 * 16 * 128, gla_gate_b + l * 256, GLA_ST, GLA_GP);
    FOR_VB(8 * (NT / 128)) {
      int tid = TID(); int mt = vb >> 3, k = vb & 7;
      if (k < 3) { EpiMlaQ epi{Q, ROPE}; gemm128<false, true>(tid, smem, P + O_MLA, PLD, nullptr, WT_UQ + (size_t)l * 384 * 256, 256, 256, mt * 128, k * 128, epi); }
      else if (k < 7) { EpiMlaKV epi{K, VT}; gemm128<false, true>(tid, smem, P + O_MLA + 256, PLD, nullptr, WT_UKV + (size_t)l * 512 * 128, 128, 128, mt * 128, (k - 3) * 128, epi); }
      else mla_krope(mt, tid, P, ROPE, K);
    }
    GRID_SYNC();
    FOR_VB(NB * 2 * 4 * 8192 / 256) ssd_B(vb, TID(), SSD_ST, SSD_DA, SSD_HIN);
    FOR_VB(NB * 2 * 4 * 2048 / 256) gla_B(vb, TID(), GLA_ST, GLA_GP);
    FOR_VB(NB * 2 * 16 * 64 / 256) s5_B(vb, TID(), s5_a_re + l * 2048, s5_a_im + l * 2048, s5_log_dt + l * 32, S5_ST);
    GRID_SYNC();
    {
      const int n_ssd = NB * NCH128 * 4, n_gla = NB * NCH64, n_s5 = NB * NCH64, n_att = NB * 4 * (LK / 256);
      FOR_VB(n_ssd + n_gla + n_s5 + n_att) {
        int v = vb;
        if (v < n_ssd) { if (l == 0 || ((v >> 2) % NCH128) >= NCC128) ssd_C(v, TID(), smem, P, XBC, XT, SSD_DA, SSD_HIN, ssd_d + l * 4, ssd_norm_g + l * 256, CAT); continue; }
        v -= n_ssd;
        if (v < n_gla) { if (l == 0 || (v % NCH64) >= NCC64) gla_C(v, TID(), smem, P, gla_gate_w + l * 2 * 16 * 128, gla_gate_b + l * 256, gla_norm_g + l * 64, GLA_ST, CAT); continue; }
        v -= n_gla;
        if (v < n_s5) { if (l == 0 || (v % NCH64) >= NCC64) s5_C(v, TID(), smem, P, s5_a_re + l * 2048, s5_a_im + l * 2048, s5_log_dt + l * 32, s5_b_re + l * 16384, s5_b_im + l * 16384,
                                  S5_CCT + (size_t)l * 65536, s5_d + l * 256, WT_GLU + (size_t)l * 65536, s5_glu_b + l * 256, S5_ST, CAT); continue; }
        v -= n_s5;
        if (l == 0 || (v % (LK / 256)) < SEQ / 256) attn_item(v, TID(), smem, Q, K, VT, CAT);
      }
      GRID_SYNC();
    }
#ifdef EMU_STOP_L0C
    g_dbg_cat = CAT; return;
#endif
    FOR_VB(8 * (nact / 128)) {
      int tid = TID(); int mt = vb / 8, nt = vb % 8;
      EpiResid epi{H, mod, 2};
      gemm128<false, false>(tid, smem, CAT, DM, nullptr, WT_OUT + (size_t)l * DM * DM, DM, DM, mt * 128, nt * 128, epi);
    }
    GRID_SYNC();
    FOR_VB(8 * (nact / 128)) {
      int tid = TID(); int mt = vb >> 3, hh = vb & 7;
      peer_route(mt, hh, tid, smem, H, GFF + l * 3 * DM, WT_PQ + (size_t)l * DM * DM, TPQ + l * 3 * DM, SKB + (size_t)l * 2 * 8 * 128 * 64, EIDX, GATE);
    }
    GRID_SYNC();
    FOR_VB(nact / 4) {
      int tid = TID(); const int row = vb * 4 + (tid >> 6);
      if (l == 0) peer_gather<false>(row, tid & 63, GFF + l * 3 * DM, mod, EIDX, GATE, UB + (size_t)l * 16384 * DM, VB + (size_t)l * 16384 * DM, H, final_norm_g, out);
      else peer_gather<true>(row, tid & 63, GFF + l * 3 * DM, mod, EIDX, GATE, UB + (size_t)l * 16384 * DM, VB + (size_t)l * 16384 * DM, H, final_norm_g, out);
    }
    if (l == 0) GRID_SYNC();
  }
}
}

extern "C" void kernel_launch(void* const* d_in, const int* in_sizes, int n_in, void* d_out, int out_size, void* d_ws,
                              size_t ws_size, hipStream_t stream) {
  Params p{};
  for (int i = 0; i < 38; ++i) p.in[i] = (const float*)d_in[i];
  p.out = (float*)d_out; p.ws = (char*)d_ws;
  if ((size_t)522000000 > ws_size) return;
  static int grid_blocks = 0;
  if (!grid_blocks) {
    int dev = 0, cus = 0, per_cu = 0;
    (void)hipGetDevice(&dev);
    (void)hipDeviceGetAttribute(&cus, hipDeviceAttributeMultiprocessorCount, dev);
#ifdef EMU
    per_cu = 1;
#else
    (void)hipFuncSetAttribute((const void*)mega, hipFuncAttributeMaxDynamicSharedMemorySize, LDS_BYTES);
    (void)hipOccupancyMaxActiveBlocksPerMultiprocessor(&per_cu, (const void*)mega, 256, LDS_BYTES);
#endif
    if (per_cu > 1) per_cu = 1;
    grid_blocks = cus * per_cu;
  }
  if (grid_blocks <= 0) return;
#ifdef EMU
  emu_launch(dim3(grid_blocks), dim3(256), true, [=]() { mega(p); });
#else
  (void)hipMemsetAsync(d_ws, 0, 16384, stream);
  void* args[] = {&p};
  hipError_t e = hipLaunchCooperativeKernel((void*)mega, dim3(grid_blocks), dim3(256), args, LDS_BYTES, stream);
  if (e != hipSuccess) fprintf(stderr, "cooperative launch failed: %s (grid %d)\n", hipGetErrorString(e), grid_blocks);
#endif
}
```
